# Optimizing an MI355X kernel written in HIP

```python
import jax, jax.numpy as jnp
from jax import lax
import numpy as np

D_MODEL = 2048
BATCH = 4
SEQ = 4096
DEPTH = 2

GRID_W = 64
CTX_LEN = 256
EPS = 1e-6

MLA_HEADS = 8
MLA_Q_RANK = 512
MLA_KV_RANK = 512
MLA_NOPE = 128
MLA_ROPE = 64
MLA_V = 128
MLA_QK = MLA_NOPE + MLA_ROPE
MLA_SCALE = MLA_QK ** -0.5
ROPE_THETA = 10000.0
ATTN_BLOCK = 128

SGU_WIDTH = 512
SGU_GROUPS = 4
SGU_GROUP_DIM = SGU_WIDTH // SGU_GROUPS
SGU_CHUNK = 128

GLA_HEADS = 4
GLA_DK = 64
GLA_DV = 128
GLA_GATE_RANK = 16
GLA_GATE_NORM = 16.0
GLA_CHUNK = 64

MIX_WIDTH = MLA_HEADS * MLA_V + SGU_WIDTH + GLA_HEADS * GLA_DV

IN_SPLITS = (MLA_Q_RANK, MLA_KV_RANK, MLA_ROPE,
             SGU_WIDTH, SGU_WIDTH,
             GLA_HEADS * GLA_DK, GLA_HEADS * GLA_DK,
             GLA_HEADS * GLA_DV, GLA_HEADS * GLA_DV,
             GLA_GATE_RANK, GLA_GATE_RANK)
D_IN = sum(IN_SPLITS)

MOE_GROUPS = 4
MOE_PER_GROUP = 4
MOE_EXPERTS = MOE_GROUPS * MOE_PER_GROUP
MOE_TOPK = 2
D_EXPERT = 1024

kernel_name = 'hybrid_mla_sgu_gla_hmoe_dit'


def rmsnorm(x, gain):
    xf = x.astype(jnp.float32)
    y = xf * lax.rsqrt(jnp.mean(xf * xf, axis=-1, keepdims=True) + EPS)
    return (y * gain.astype(jnp.float32)).astype(x.dtype)


def modulate(h, shift, scale):
    return h * (1 + scale) + shift


def split_in(z):
    return jnp.split(z, np.cumsum(IN_SPLITS)[:-1].tolist(), axis=-1)


def axial_rope_tables(n_tokens):
    rows = n_tokens // GRID_W
    row = jnp.repeat(jnp.arange(rows, dtype=jnp.int32), GRID_W)
    col = jnp.tile(jnp.arange(GRID_W, dtype=jnp.int32), rows)
    n_freq = MLA_ROPE // 4
    inv_freq = ROPE_THETA ** (-jnp.arange(n_freq, dtype=jnp.float32) / n_freq)
    ang = jnp.concatenate([row[:, None].astype(jnp.float32) * inv_freq,
                           col[:, None].astype(jnp.float32) * inv_freq], axis=-1)
    return jnp.cos(ang), jnp.sin(ang)


def apply_axial_rope(t, cos, sin):
    n_freq = MLA_ROPE // 4

    def rot(u, c, s):
        u1, u2 = jnp.split(u, 2, axis=-1)
        return jnp.concatenate([u1 * c - u2 * s, u1 * s + u2 * c], axis=-1)

    t_row, t_col = jnp.split(t, 2, axis=-1)
    return jnp.concatenate([rot(t_row, cos[..., :n_freq], sin[..., :n_freq]),
                            rot(t_col, cos[..., n_freq:], sin[..., n_freq:])], axis=-1)


def mla_qkv(c_q, c_kv, k_pe_shared, q_norm, w_uq, kv_norm, w_ukv, q_gain, k_gain, rope):
    B, N, _ = c_q.shape
    q = (rmsnorm(c_q, q_norm) @ w_uq).reshape(B, N, MLA_HEADS, MLA_QK)
    kv = (rmsnorm(c_kv, kv_norm) @ w_ukv).reshape(B, N, MLA_HEADS, MLA_NOPE + MLA_V)
    k_nope, v = jnp.split(kv, [MLA_NOPE], axis=-1)
    k_pe = jnp.broadcast_to(k_pe_shared[:, :, None, :], (B, N, MLA_HEADS, MLA_ROPE))
    k = jnp.concatenate([k_nope, k_pe], axis=-1)
    q = rmsnorm(q, q_gain)
    k = rmsnorm(k, k_gain)
    if rope is not None:
        cos, sin = rope
        q = jnp.concatenate([q[..., :MLA_NOPE], apply_axial_rope(q[..., MLA_NOPE:], cos, sin)], axis=-1)
        k = jnp.concatenate([k[..., :MLA_NOPE], apply_axial_rope(k[..., MLA_NOPE:], cos, sin)], axis=-1)
    return q, k, v


def latent_attention(q, k, v, k_ctx, v_ctx):
    B, S, H, _ = q.shape
    keys = jnp.concatenate([k_ctx, k], axis=1)
    vals = jnp.concatenate([v_ctx, v], axis=1)
    n_blk = S // ATTN_BLOCK
    q_blocks = q.reshape(B, n_blk, ATTN_BLOCK, H, MLA_QK).transpose(1, 0, 2, 3, 4)

    def one_block(qb):
        s = jnp.einsum('bqhd,bkhd->bhqk', qb, keys).astype(jnp.float32) * MLA_SCALE
        p = jax.nn.softmax(s, axis=-1).astype(vals.dtype)
        return jnp.einsum('bhqk,bkhd->bqhd', p, vals)

    o = lax.map(one_block, q_blocks)
    return o.transpose(1, 0, 2, 3, 4).reshape(B, S, H * MLA_V)


def context_attention(q, k, v):
    B, L, H, _ = q.shape
    s = jnp.einsum('bqhd,bkhd->bhqk', q, k).astype(jnp.float32) * MLA_SCALE
    p = jax.nn.softmax(s, axis=-1).astype(v.dtype)
    return jnp.einsum('bhqk,bkhd->bqhd', p, v).reshape(B, L, H * MLA_V)


def spatial_gating(zu, zv, v_gain, w_s, b_s):
    B, N, _ = zu.shape
    shape = (B, N // SGU_CHUNK, SGU_CHUNK, SGU_GROUPS, SGU_GROUP_DIM)
    u = jax.nn.gelu(zu).reshape(shape)
    v = rmsnorm(jax.nn.gelu(zv).reshape(shape), v_gain)
    v = jnp.einsum('gts,bcsgd->bctgd', w_s, v) + b_s.T[:, :, None]
    return (u * v).reshape(B, N, SGU_WIDTH)


def gla_inputs(zq, zk, zv, zg_f, zg_b, wg_f, bg_f, wg_b, bg_b):
    B, N, _ = zq.shape
    q = zq.reshape(B, N, GLA_HEADS, GLA_DK) * GLA_DK ** -0.5
    k = zk.reshape(B, N, GLA_HEADS, GLA_DK)
    v = zv.reshape(B, N, GLA_HEADS, GLA_DV)
    g_f = (jax.nn.log_sigmoid((zg_f @ wg_f + bg_f).astype(jnp.float32)) / GLA_GATE_NORM).reshape(B, N, GLA_HEADS, GLA_DK)
    g_b = (jax.nn.log_sigmoid((zg_b @ wg_b + bg_b).astype(jnp.float32)) / GLA_GATE_NORM).reshape(B, N, GLA_HEADS, GLA_DK)
    return q, k, v, g_f, g_b


def gla_scan(q, k, v, g, s0):
    B, N, H, _ = q.shape
    n_chunk = N // GLA_CHUNK

    def to_chunks(t):
        return t.reshape(B, n_chunk, GLA_CHUNK, H, t.shape[-1]).transpose(1, 0, 3, 2, 4)

    incl = jnp.tril(jnp.ones((GLA_CHUNK, GLA_CHUNK), dtype=bool))[:, :, None]

    def step(S, inp):
        qi, ki, vi, gi = inp
        qf, kf, vf = qi.astype(jnp.float32), ki.astype(jnp.float32), vi.astype(jnp.float32)
        b = jnp.cumsum(gi, axis=2)
        o_inter = jnp.einsum('bhtd,bhde->bhte', qf * jnp.exp(b), S)
        diff = b[:, :, :, None, :] - b[:, :, None, :, :]
        decay = jnp.exp(jnp.where(incl, diff, -jnp.inf))
        a = jnp.einsum('bhtd,bhsd,bhtsd->bhts', qf, kf, decay)
        o = o_inter + jnp.einsum('bhts,bhse->bhte', a, vf)
        b_last = b[:, :, -1:, :]
        S = jnp.exp(b_last[:, :, 0, :])[..., None] * S + jnp.einsum('bhsd,bhse->bhde', kf * jnp.exp(b_last - b), vf)
        return S, o

    S, o = lax.scan(step, s0, (to_chunks(q), to_chunks(k), to_chunks(v), to_chunks(g)))
    o = o.transpose(1, 0, 3, 2, 4).reshape(B, N, H, GLA_DV).astype(v.dtype)
    return o, S


def gla_bidirectional(q, k, v, g_f, g_b, s0_f, s0_b):
    flip = lambda t: jnp.flip(t, axis=1)
    o_f, s_f = gla_scan(q, k, v, g_f, s0_f)
    o_b, s_b = gla_scan(flip(q), flip(k), flip(v), flip(g_b), s0_b)
    return o_f + flip(o_b), s_f, s_b


def gla_final_state(k, v, g):
    G = jnp.cumsum(g, axis=1)
    w = jnp.exp(G[:, -1:] - G)
    return jnp.einsum('bnhd,bnhe->bhde', k.astype(jnp.float32) * w, v.astype(jnp.float32))


def gla_output(o, r, gain):
    B, N = o.shape[:2]
    return rmsnorm(o, gain).reshape(B, N, GLA_HEADS * GLA_DV) * jax.nn.silu(r)


def hier_moe(h, w_group, b_group, w_expert, b_expert, w1, w3, w2):
    g_prob = jax.nn.softmax((h @ w_group + b_group).astype(jnp.float32), axis=-1)
    g_w, g_sel = lax.top_k(g_prob, 1)
    e_logits = (h @ w_expert + b_expert).astype(jnp.float32)
    e_logits = e_logits.reshape(e_logits.shape[:-1] + (MOE_GROUPS, MOE_PER_GROUP))
    e_in = jnp.take_along_axis(e_logits, g_sel[..., None], axis=-2)[..., 0, :]
    e_w, e_sel = lax.top_k(jax.nn.softmax(e_in, axis=-1), MOE_TOPK)
    e_w = e_w / jnp.sum(e_w, axis=-1, keepdims=True)
    expert_id = g_sel * MOE_PER_GROUP + e_sel
    combine = jnp.sum(jax.nn.one_hot(expert_id, MOE_EXPERTS, dtype=jnp.float32)
                      * (g_w * e_w)[..., None], axis=-2).astype(h.dtype)
    out = jnp.zeros_like(h)
    for e in range(MOE_EXPERTS):
        act = jax.nn.silu(h @ w1[e]) * (h @ w3[e])
        out = out + combine[..., e:e + 1] * (act @ w2[e])
    return out


def setup_inputs(seed: int = 0) -> dict:
    key = jax.random.key(seed)
    keys = jax.random.split(key, 40)
    counter = [0]

    def nrm(shape, scale=1.0):
        k = keys[counter[0]]
        counter[0] += 1
        return jax.random.normal(k, shape, jnp.float32) * scale

    def gain(shape):
        return 1.0 + nrm(shape, 0.02)

    D = D_MODEL
    return {
        'x': nrm((BATCH, SEQ, D)),
        'c': nrm((BATCH, D)),
        'ctx': nrm((BATCH, CTX_LEN, D)),
        'c_ctx': nrm((D,)),
        'norm1_g': gain((DEPTH, D)),
        'norm2_g': gain((DEPTH, D)),
        'ada_w': nrm((DEPTH, D, 6 * D), 0.5 * D ** -0.5),
        'ada_b': nrm((DEPTH, 6 * D), 0.02),
        'w_in': nrm((DEPTH, D, D_IN), D ** -0.5),
        'mla_q_norm': gain((DEPTH, MLA_Q_RANK)),
        'mla_w_uq': nrm((DEPTH, MLA_Q_RANK, MLA_HEADS * MLA_QK), MLA_Q_RANK ** -0.5),
        'mla_kv_norm': gain((DEPTH, MLA_KV_RANK)),
        'mla_w_ukv': nrm((DEPTH, MLA_KV_RANK, MLA_HEADS * (MLA_NOPE + MLA_V)), MLA_KV_RANK ** -0.5),
        'mla_q_gain': gain((DEPTH, MLA_QK)),
        'mla_k_gain': gain((DEPTH, MLA_QK)),
        'sgu_norm': gain((DEPTH, SGU_GROUPS, SGU_GROUP_DIM)),
        'sgu_w': nrm((DEPTH, SGU_GROUPS, SGU_CHUNK, SGU_CHUNK), SGU_CHUNK ** -0.5),
        'sgu_b': gain((DEPTH, SGU_GROUPS, SGU_CHUNK)),
        'gla_wg_f': nrm((DEPTH, GLA_GATE_RANK, GLA_HEADS * GLA_DK), GLA_GATE_RANK ** -0.5),
        'gla_bg_f': nrm((DEPTH, GLA_HEADS * GLA_DK), 0.1),
        'gla_wg_b': nrm((DEPTH, GLA_GATE_RANK, GLA_HEADS * GLA_DK), GLA_GATE_RANK ** -0.5),
        'gla_bg_b': nrm((DEPTH, GLA_HEADS * GLA_DK), 0.1),
        'gla_out_norm': gain((DEPTH, GLA_DV)),
        'w_out': nrm((DEPTH, MIX_WIDTH, D), MIX_WIDTH ** -0.5),
        'moe_w_group': nrm((DEPTH, D, MOE_GROUPS), D ** -0.5),
        'moe_b_group': nrm((DEPTH, MOE_GROUPS), 0.01),
        'moe_w_expert': nrm((DEPTH, D, MOE_EXPERTS), D ** -0.5),
        'moe_b_expert': nrm((DEPTH, MOE_EXPERTS), 0.01),
        'moe_w1': nrm((DEPTH, MOE_EXPERTS, D, D_EXPERT), D ** -0.5),
        'moe_w3': nrm((DEPTH, MOE_EXPERTS, D, D_EXPERT), D ** -0.5),
        'moe_w2': nrm((DEPTH, MOE_EXPERTS, D_EXPERT, D), D_EXPERT ** -0.5),
    }


def reference(x, c, ctx, c_ctx, norm1_g, norm2_g, ada_w, ada_b, w_in,
              mla_q_norm, mla_w_uq, mla_kv_norm, mla_w_ukv, mla_q_gain, mla_k_gain,
              sgu_norm, sgu_w, sgu_b,
              gla_wg_f, gla_bg_f, gla_wg_b, gla_bg_b, gla_out_norm,
              w_out, moe_w_group, moe_b_group, moe_w_expert, moe_b_expert, moe_w1, moe_w3, moe_w2):
    B, S, _ = x.shape
    cos, sin = axial_rope_tables(S)
    rope = (cos[:, None, :].astype(x.dtype), sin[:, None, :].astype(x.dtype))
    zero_state = jnp.zeros((B, GLA_HEADS, GLA_DK, GLA_DV), jnp.float32)

    for l in range(DEPTH):
        ctx_out = l < DEPTH - 1
        mod_x = jnp.split((jax.nn.silu(c) @ ada_w[l] + ada_b[l])[:, None, :], 6, axis=-1)
        mod_c = jnp.split((jax.nn.silu(c_ctx) @ ada_w[l] + ada_b[l])[None, None, :], 6, axis=-1)

        h = modulate(rmsnorm(x, norm1_g[l]), mod_x[0], mod_x[1])
        hc = modulate(rmsnorm(ctx, norm1_g[l]), mod_c[0], mod_c[1])
        (cq_x, ckv_x, kpe_x, zu_x, zv_x, gq_x, gk_x, gv_x, gr_x, ggf_x, ggb_x) = split_in(h @ w_in[l])
        (cq_c, ckv_c, kpe_c, zu_c, zv_c, gq_c, gk_c, gv_c, gr_c, ggf_c, ggb_c) = split_in(hc @ w_in[l])

        q_x, k_x, v_x = mla_qkv(cq_x, ckv_x, kpe_x, mla_q_norm[l], mla_w_uq[l], mla_kv_norm[l],
                                mla_w_ukv[l], mla_q_gain[l], mla_k_gain[l], rope)
        q_c, k_c, v_c = mla_qkv(cq_c, ckv_c, kpe_c, mla_q_norm[l], mla_w_uq[l], mla_kv_norm[l],
                                mla_w_ukv[l], mla_q_gain[l], mla_k_gain[l], None)
        a_x = latent_attention(q_x, k_x, v_x, k_c, v_c)

        b_x = spatial_gating(zu_x, zv_x, sgu_norm[l], sgu_w[l], sgu_b[l])

        q_gc, k_gc, v_gc, gf_c, gb_c = gla_inputs(gq_c, gk_c, gv_c, ggf_c, ggb_c,
                                                  gla_wg_f[l], gla_bg_f[l], gla_wg_b[l], gla_bg_b[l])
        if ctx_out:
            o_gc, s_f, s_b = gla_bidirectional(q_gc, k_gc, v_gc, gf_c, gb_c, zero_state, zero_state)
        else:
            s_f = gla_final_state(k_gc, v_gc, gf_c)
            s_b = gla_final_state(jnp.flip(k_gc, axis=1), jnp.flip(v_gc, axis=1), jnp.flip(gb_c, axis=1))
        q_gx, k_gx, v_gx, gf_x, gb_x = gla_inputs(gq_x, gk_x, gv_x, ggf_x, ggb_x,
                                                  gla_wg_f[l], gla_bg_f[l], gla_wg_b[l], gla_bg_b[l])
        o_gx, _, _ = gla_bidirectional(q_gx, k_gx, v_gx, gf_x, gb_x, s_f, s_b)
        c_x = gla_output(o_gx, gr_x, gla_out_norm[l])

        mix_x = jnp.concatenate([a_x, b_x, c_x], axis=-1)
        x = x + mod_x[2] * (mix_x @ w_out[l])

        h2 = modulate(rmsnorm(x, norm2_g[l]), mod_x[3], mod_x[4])
        x = x + mod_x[5] * hier_moe(h2, moe_w_group[l], moe_b_group[l], moe_w_expert[l], moe_b_expert[l],
                                    moe_w1[l], moe_w3[l], moe_w2[l])

        if ctx_out:
            a_c = context_attention(q_c, k_c, v_c)
            b_c = spatial_gating(zu_c, zv_c, sgu_norm[l], sgu_w[l], sgu_b[l])
            c_c = gla_output(o_gc, gr_c, gla_out_norm[l])
            mix_c = jnp.concatenate([a_c, b_c, c_c], axis=-1)
            ctx = ctx + mod_c[2] * (mix_c @ w_out[l])
            h2c = modulate(rmsnorm(ctx, norm2_g[l]), mod_c[3], mod_c[4])
            ctx = ctx + mod_c[5] * hier_moe(h2c, moe_w_group[l], moe_b_group[l], moe_w_expert[l], moe_b_expert[l],
                                            moe_w1[l], moe_w3[l], moe_w2[l])
    return x
```

```cpp
#include <hip/hip_runtime.h>
#include <stdint.h>
#include <stdio.h>

#ifndef MK_ONE_LAUNCH
#define MK_ONE_LAUNCH 1
#endif

#ifndef RP_W
#define RP_W 1
#endif
#ifndef RP_ROWS
#define RP_ROWS 1
#endif
#ifndef RP_GIN
#define RP_GIN 1
#endif
#ifndef RP_UP
#define RP_UP 1
#endif
#ifndef RP_SGU
#define RP_SGU 1
#endif
#ifndef RP_GLAL
#define RP_GLAL 1
#endif
#ifndef RP_SCAN
#define RP_SCAN 1
#endif
#ifndef RP_ATTN
#define RP_ATTN 1
#endif
#ifndef RP_GLAO
#define RP_GLAO 1
#endif
#ifndef RP_OUT
#define RP_OUT 1
#endif
#ifndef RP_PERM
#define RP_PERM 1
#endif
#ifndef RP_M1
#define RP_M1 1
#endif
#ifndef RP_M2
#define RP_M2 1
#endif
#ifndef GS1
#define GS1 1
#endif
#ifndef GS2
#define GS2 1
#endif
#ifndef GS4
#define GS4 1
#endif
#ifndef GS5
#define GS5 1
#endif
#ifndef ALIGN_PLAIN
#define ALIGN_PLAIN true
#endif
#ifndef W_NT
#define W_NT 1
#endif
#ifndef W_NTS
#define W_NTS 1
#endif
#ifndef MOE_BNT
#define MOE_BNT 0
#endif
#ifndef NT2
#define NT2 1
#endif
#if NT2
#define NT_LD(p) __builtin_nontemporal_load(p)
#define NT_ST(v, p) __builtin_nontemporal_store(v, p)
#else
#define NT_LD(p) (*(p))
#define NT_ST(v, p) (*(p) = (v))
#endif
#ifndef RP_EPI
#define RP_EPI 1
#endif
#ifndef RP_ADA
#define RP_ADA 1
#endif
#ifndef RP_TR
#define RP_TR 1
#endif
#ifndef RP_RT
#define RP_RT 1
#endif
#ifndef RP_BAR
#define RP_BAR 1
#endif
#ifndef MOE_FP8
#ifndef OUT_FP8
#define OUT_FP8 1
#endif
#ifndef ATTN_NBUF
#define ATTN_NBUF 3
#endif
#ifndef ADA_KSPLIT
#define ADA_KSPLIT 1
#endif
#ifndef GL_BF16
#define GL_BF16 0
#endif
#ifndef MOE_GATHER
#define MOE_GATHER 1
#endif
#ifndef W_FILL
#define W_FILL 0
#endif
#ifndef ALIGN_F8
#define ALIGN_F8 ALIGN_PLAIN
#endif
#ifndef F8_SP2
#define F8_SP2 true
#endif
#define MOE_FP8 1
#endif
#define GAS __attribute__((address_space(1)))
#define LAS __attribute__((address_space(3)))
typedef unsigned short bf16_t;
#if OUT_FP8
typedef unsigned char MixT;
#else
typedef unsigned short MixT;
#endif
typedef short bf16x8 __attribute__((ext_vector_type(8)));
typedef short s16x4 __attribute__((ext_vector_type(4)));
typedef float f32x2 __attribute__((ext_vector_type(2)));
typedef float f32x4 __attribute__((ext_vector_type(4)));
typedef float f32x16 __attribute__((ext_vector_type(16)));
typedef unsigned u32x2 __attribute__((ext_vector_type(2)));
typedef unsigned u32x4 __attribute__((ext_vector_type(4)));

constexpr int DM = 2048, NB = 4, SEQ = 4096, CTXL = 256, DEPTH = 2;
constexpr int NLAT = NB * SEQ, NCTX = NB * CTXL, NTOK = NLAT + NCTX;
constexpr int DIN = 3680, DINP = 3840;
constexpr int ZC_CQ = 0, ZC_CKV = 512, ZC_KPE = 1024, ZC_ZU = 1088, ZC_ZV = 1600, ZC_GQ = 2112, ZC_GK = 2368, ZC_GV = 2624, ZC_GR = 3136, ZC_GGF = 3648, ZC_GGB = 3664;
constexpr int NH = 8, QKD = 192, NOPE = 128, ROPE = 64, VD = 128;
constexpr int QLD = NH * QKD  , VLD = NH * VD  ;
constexpr int GH = 4, GDK = 64, GDV = 128, GCH = 64, NCHUNK = (SEQ + CTXL) / GCH  ;
constexpr int NEXP = 16, DEXP = 1024;
constexpr float EPS = 1e-6f;
constexpr int MAXSLOT_TILES = 152, MAXSLOTS = MAXSLOT_TILES * 256;

constexpr size_t MiB = 1u << 20;
constexpr size_t WS_CTL = 0, CTL_ZERO_BYTES = ADA_KSPLIT ? (1u << 20) + 2 * 5 * 12288 * 4 : 64 * 1024;
constexpr size_t WS_MOD = 1 * MiB;
constexpr size_t WS_ROPE = WS_MOD + 512 * 1024;
constexpr size_t WS_RSQ = 2 * MiB;
constexpr size_t WS_TOKE = 4 * MiB;
constexpr size_t WS_TOKI = WS_TOKE + 256 * 1024;
constexpr size_t WS_TOKS = WS_TOKI + 256 * 1024;
constexpr size_t WS_CW = WS_TOKS + 256 * 1024;
constexpr size_t WS_LIST = WS_CW + 256 * 1024;
constexpr size_t WS_GLAM = 6 * MiB;
constexpr size_t WS_W = 8 * MiB;
constexpr size_t WEB = MOE_FP8 ? 1 : 2;
constexpr size_t W_IN = 0;
constexpr size_t W_UQ = W_IN + (size_t)DINP * DM * 2;
constexpr size_t W_UKV = W_UQ + (size_t)2048 * 512 * 2;
constexpr size_t W_OUT = W_UKV + (size_t)2048 * 512 * 2;
constexpr size_t W_GU = W_OUT + (size_t)2048 * 2048 * 2;
constexpr size_t W_2 = W_GU + (size_t)NEXP * 2048 * 2048 * WEB;
constexpr size_t W_SGU = W_2 + (size_t)NEXP * 2048 * 1024 * WEB;
constexpr size_t W_BYTES = W_SGU + (size_t)4 * 128 * 128 * 2;
constexpr size_t WL_BYTES = ((W_BYTES + MiB - 1) / MiB) * MiB;
constexpr size_t WS_X1 = WS_W + DEPTH * WL_BYTES;
constexpr size_t XBYTES = (size_t)NTOK * DM * 4;
constexpr size_t WS_X2 = WS_X1 + XBYTES;
constexpr size_t WS_H = WS_X2 + XBYTES;
constexpr size_t WS_R = WS_H + (size_t)NTOK * DM * 2;
constexpr size_t R_Z = 0;
constexpr size_t R_Q = R_Z + (size_t)NTOK * DINP * 2;
constexpr size_t R_K = R_Q + (size_t)NTOK * QLD * 2;
constexpr size_t R_V = R_K + (size_t)NTOK * QLD * 2;
constexpr size_t R_MIX = R_V + (size_t)NTOK * VLD * 2;
constexpr size_t GSTATE_ELEMS = (size_t)NB * NCHUNK * GH * 2 * GDV * GDK;
constexpr size_t R_GL = R_MIX + (size_t)NTOK * DM * 2;
constexpr size_t R_GS = R_GL + GSTATE_ELEMS * 4;
constexpr size_t R_GQK = R_GS + GSTATE_ELEMS * 2;
constexpr size_t R_GVT = R_GQK + (size_t)NB * NCHUNK * GH * 4 * 64 * 64 * 2;
constexpr size_t R_END_MIX = R_GVT + (size_t)NB * NCHUNK * GH * 128 * 64 * 2;
constexpr size_t R_H2S = 0;
constexpr size_t R_ACT = R_H2S + (size_t)MAXSLOTS * DM * 2;
constexpr size_t R_Y = R_ACT + (size_t)MAXSLOTS * DEXP * 2;
constexpr size_t R_END_MOE = R_Y + (size_t)MAXSLOTS * DM * 2;
constexpr size_t WS_END = WS_R + (R_END_MIX > R_END_MOE ? R_END_MIX : R_END_MOE);
static_assert(WS_END < 1250ull * 1000 * 1000, "workspace map must fit under sum(inputs)");
constexpr int CW_BAR = 1024;
constexpr int CW_CNT = 8192;
constexpr int CW_Q = 8192 + 256;
static_assert((CW_BAR + 3456) <= CW_CNT && (CW_Q + 64 * 8) * 4 <= 64 * 1024, "ctl map");

constexpr int RING_BYTES = 131072;
constexpr int SCR_OFF = RING_BYTES;
constexpr int SCR_BYTES = 16384;
constexpr int MISC_OFF = (ATTN_NBUF == 3) ? 154 * 1024 : SCR_OFF + SCR_BYTES;
constexpr int LDS_BYTES = MISC_OFF + 256;

__device__ __forceinline__ unsigned cvt_pk_bf16(float lo, float hi) { unsigned r; asm("v_cvt_pk_bf16_f32 %0, %1, %2" : "=v"(r) : "v"(lo), "v"(hi)); return r; }
__device__ __forceinline__ unsigned f2bf(float f) { return cvt_pk_bf16(f, f) & 0xffffu; }
__device__ __forceinline__ unsigned pk2(float lo, float hi) { return cvt_pk_bf16(lo, hi); }
__device__ __forceinline__ unsigned f2bf_sw(float f) { unsigned u = __float_as_uint(f); u += 0x7FFFu + ((u >> 16) & 1u); return u >> 16; }
__device__ __forceinline__ float bf2f(unsigned short b) { return __builtin_bit_cast(float, ((unsigned)b) << 16); }
__device__ __forceinline__ float bflo(unsigned w) { return __builtin_bit_cast(float, w << 16); }
__device__ __forceinline__ float bfhi(unsigned w) { return __builtin_bit_cast(float, w & 0xffff0000u); }
__device__ __forceinline__ unsigned pk4_fp8(float a, float b, float c, float d) { int w = __builtin_amdgcn_cvt_pk_fp8_f32(a, b, 0, false); w = __builtin_amdgcn_cvt_pk_fp8_f32(c, d, w, true); return (unsigned)w; }
__device__ __forceinline__ unsigned pk2_fp8(float a, float b) { return (unsigned)__builtin_amdgcn_cvt_pk_fp8_f32(a, b, 0, false) & 0xFFFFu; }
__device__ __forceinline__ float clamp8(float x) { return fminf(fmaxf(x, -448.0f), 448.0f); }
constexpr float W8_SCALE = 32.0f;
__device__ __forceinline__ float wave_sum(float v) {
#pragma unroll
    for (int o = 1; o < 64; o <<= 1) v += __shfl_xor(v, o);
    return v;
}
__device__ __forceinline__ float silu_f(float x) { return x / (1.f + __expf(-x)); }
__device__ __forceinline__ float gelu_tanh_f(float x) {
    const float u = 0.7978845608028654f * (x + 0.044715f * x * x * x);
    return x / (1.f + __expf(-2.f * u));
}
__device__ __forceinline__ float logsigmoid_f(float x) { return fminf(x, 0.f) - log1pf(__expf(-fabsf(x))); }
#define LDS_WAIT() asm volatile("s_waitcnt lgkmcnt(0)" ::: "memory")
__device__ __forceinline__ void lds_barrier() { asm volatile("s_waitcnt lgkmcnt(0)" ::: "memory"); __builtin_amdgcn_s_barrier(); asm volatile("" ::: "memory"); }
#define VM_WAIT() asm volatile("s_waitcnt vmcnt(0)" ::: "memory")

__device__ __forceinline__ int mod_row_of(int row) { return row < NLAT ? (row >> 12) : 4; }
__device__ __forceinline__ int lane_id() { int l; asm volatile("v_mbcnt_lo_u32_b32 %0, -1, 0\n\tv_mbcnt_hi_u32_b32 %0, -1, %0" : "=v"(l)); return l; }
#define XB_TMO      128
#define XB_XCNT(j)  (256  + 64 * (j))
#define XB_XSUB(j)  (1280 + 64 * (j))
#define XB_XGEN(j)  (2304 + 64 * (j))
#define XB_TOP      3328
#define XB_TOPGEN   3392
#define XCD_BAR_WORDS 3456
#define XB_SPIN_CAP (1u << 18)
#define LAS __attribute__((address_space(3)))

__device__ __forceinline__ unsigned xb_ld(unsigned* p)              { return __hip_atomic_load(p, __ATOMIC_RELAXED, __HIP_MEMORY_SCOPE_AGENT); }
__device__ __forceinline__ unsigned xb_add(unsigned* p, unsigned v) { return __hip_atomic_fetch_add(p, v, __ATOMIC_RELAXED, __HIP_MEMORY_SCOPE_AGENT); }
__device__ __forceinline__ unsigned xb_xcc_id() { return (unsigned)__builtin_amdgcn_s_getreg((3 << 11) | 20) & 0xFu; }
#define XB_SPIN(cond, bar) do { unsigned _sp = 0; while (cond) { __builtin_amdgcn_s_sleep(1); \
    if ((++_sp & 255u) == 0u) { if (xb_ld(&(bar)[XB_TMO])) break; if (_sp > XB_SPIN_CAP) { atomicAdd(&(bar)[XB_TMO], 1u); break; } } } } while (0)

struct XcdBarrier {
    unsigned* bar; unsigned x;
    volatile LAS unsigned* st;
};

__device__ __forceinline__ XcdBarrier xcd_barrier_post(unsigned* bar, volatile LAS unsigned* st) {
    XcdBarrier b; b.bar = bar; b.x = xb_xcc_id(); b.st = st;
    if (threadIdx.x == 0) (void)xb_add(&bar[XB_XCNT(b.x)], 1u);
    return b;
}
__device__ __forceinline__ void xcd_barrier_complete(unsigned* bar, unsigned x, unsigned& nloc, unsigned& nx) {
    const unsigned G = gridDim.x * gridDim.y * gridDim.z;
    unsigned sum, cnt, mine, sp = 0u;
    for (;;) {
        sum = 0u; cnt = 0u; mine = 0u;
#pragma unroll
        for (unsigned j = 0; j < 16; ++j) { const unsigned c = xb_ld(&bar[XB_XCNT(j)]); sum += c; cnt += (c > 0u) ? 1u : 0u; mine = (j == x) ? c : mine; }
        if (sum == G) break;
        __builtin_amdgcn_s_sleep(1);
        if ((++sp & 255u) == 0u) { if (xb_ld(&bar[XB_TMO])) break; if (sp > XB_SPIN_CAP) { atomicAdd(&bar[XB_TMO], 1u); break; } }
    }
    nloc = mine > 0u ? mine : 1u; nx = cnt > 0u ? cnt : 1u;
}

__device__ __forceinline__ void xcd_barrier(const XcdBarrier& b) {
    asm volatile("s_waitcnt vmcnt(0)" ::: "memory");
    __syncthreads();
    if (threadIdx.x == 0) {
        unsigned* bar = b.bar;
        __builtin_amdgcn_s_waitcnt(0);
        unsigned nloc = b.st[0], nx = b.st[1];
        if (nloc == 0u) { xcd_barrier_complete(bar, b.x, nloc, nx); b.st[0] = nloc; b.st[1] = nx; }
        const unsigned old = xb_add(&bar[XB_XSUB(b.x)], 1u);
        const unsigned gen = old / nloc;
        if (old + 1u == (gen + 1u) * nloc) {
            __builtin_amdgcn_fence(__ATOMIC_RELEASE, "agent");
            asm volatile("s_waitcnt vmcnt(0)" ::: "memory");
            const unsigned og = xb_add(&bar[XB_TOP], 1u);
            const unsigned tg = og / nx;
            if (og + 1u == (tg + 1u) * nx) xb_add(&bar[XB_TOPGEN], 1u);
            else XB_SPIN(xb_ld(&bar[XB_TOPGEN]) == tg, bar);
            __builtin_amdgcn_fence(__ATOMIC_ACQUIRE, "agent");
            xb_add(&bar[XB_XGEN(b.x)], 1u);
            asm volatile("s_waitcnt vmcnt(0)" ::: "memory");
        } else {
            XB_SPIN(xb_ld(&bar[XB_XGEN(b.x)]) == gen, bar);
            __builtin_amdgcn_fence(__ATOMIC_ACQUIRE, "agent");
            asm volatile("s_waitcnt vmcnt(0)" ::: "memory");
        }
    }
    __syncthreads();
}

namespace pg8 {
constexpr int BM = 256, BK = 64, HALF = 128, HTB = HALF * BK * 2  , STAGE_BYTES = 8 * HTB;
static_assert(STAGE_BYTES == RING_BYTES, "ring");
__host__ __device__ __forceinline__ int lds_byte(int r, int c) { const int st = (r >> 4) * 2 + (c >> 5), rr = r & 15, cc = c & 31, ob = rr * 64 + cc * 2; return st * 1024 + (ob ^ (((ob >> 9) & 1) << 5)); }
__host__ __device__ __forceinline__ void stage_rc(int b, int& R, int& C) { const int st = b / 1024, sb = b % 1024, swz = sb ^ (((sb >> 9) & 1) << 5); R = (st >> 1) * 16 + swz / 64; C = (st & 1) * 32 + (swz % 64) / 2; }
__host__ __device__ __forceinline__ int perm32(int rho) { const int n = rho >> 4, i = rho & 15; return 8 * (i >> 2) + 4 * n + (i & 3); }

struct Unit { int pm, pn, aux; };

#ifndef PG8_SP2
#define PG8_SP2 true
#endif
typedef int v8i __attribute__((ext_vector_type(8)));
typedef int i32x4_ __attribute__((ext_vector_type(4)));
template <class Epi, class Sched, bool F8 = false, bool ALIGN_EPI = true, bool SP2 = PG8_SP2>
__device__ __forceinline__ void gemm_phase(const int tid, LAS unsigned char* lds, LAS unsigned char* scr, const int ldaB, const int KB, const Sched& S, const Epi& E) {
    const int wid = __builtin_amdgcn_readfirstlane(tid >> 6), lane = tid & 63, wr = wid >> 2, wc = wid & 3, fr = lane & 15, fq = lane >> 4;
    const int nt = KB / 128;
    constexpr bool GA = Sched::GATHER;
    static_assert(!GA || SP2, "gather: SP2 schedule only");
    unsigned voffA[2], voffB[2]; int gR[2];
#pragma unroll
    for (int i = 0; i < 2; ++i) { int R, C; stage_rc(tid * 16 + i * 8192, R, C); const int Rb = Epi::PERM ? ((R & ~31) + perm32(R & 31)) : R;
        voffA[i] = GA ? (unsigned)(C * 2) : (unsigned)(R * ldaB + C * 2); voffB[i] = (unsigned)(Rb * KB + C * 2); gR[i] = R; }
    unsigned gC[2][2], gN[2][2];
#define PG8_GFETCH(g, uidx) do { if constexpr (GA) { _Pragma("unroll") for (int h_ = 0; h_ < 2; ++h_) _Pragma("unroll") for (int i_ = 0; i_ < 2; ++i_) g[h_][i_] = S.gtab[(uidx) * 256 + h_ * 128 + gR[i_]] + voffA[i_]; } } while (0)
#define PG8_STAGE_A(bufoff, soff, h, koff) do { if constexpr (GA) PG8_STAGE(bufoff, rsA, koff, gC[h]); else PG8_STAGE(bufoff, rsA, soff, voffA); } while (0)
    const unsigned kstep = 128u;
    const unsigned hA = (unsigned)HALF * ldaB, hB = (unsigned)HALF * KB;
    const __amdgpu_buffer_rsrc_t rsA = __builtin_amdgcn_make_buffer_rsrc((void*)S.a_base(), 0, 0x7ffffff0, 0x00020000), rsB = __builtin_amdgcn_make_buffer_rsrc((void*)S.b_base(), 0, 0x7ffffff0, 0x00020000);
    const unsigned ldsw = (unsigned)wid * 1024u;
    const int aoff = F8 ? lds_byte(wr * 64 + fr, fq * 16) : lds_byte(wr * 64 + fr, fq * 8), boff = F8 ? lds_byte(wc * 32 + fr, fq * 16) : lds_byte(wc * 32 + fr, fq * 8);
    const int aoff1 = lds_byte(wr * 64 + fr, fq * 16 + 8), boff1 = lds_byte(wc * 32 + fr, fq * 16 + 8);
#define PG8_SA(b, h) (((b) * 2 + (h)) * HTB)
#define PG8_SB(b, h) ((4 + (b) * 2 + (h)) * HTB)
#define PG8_STAGE(bufoff, rs, soff, voff) do { _Pragma("unroll") for (int _i = 0; _i < 2; ++_i) { \
        if constexpr (Sched::B_NT) { if (&(voff) == &voffB) __builtin_amdgcn_raw_ptr_buffer_load_lds(rs, (LAS void*)(lds + (bufoff) + ldsw + _i * 8192), 16, (int)(voff)[_i], (int)(soff), 0, 2); \
                                     else __builtin_amdgcn_raw_ptr_buffer_load_lds(rs, (LAS void*)(lds + (bufoff) + ldsw + _i * 8192), 16, (int)(voff)[_i], (int)(soff), 0, 0); } \
        else __builtin_amdgcn_raw_ptr_buffer_load_lds(rs, (LAS void*)(lds + (bufoff) + ldsw + _i * 8192), 16, (int)(voff)[_i], (int)(soff), 0, 0); } } while (0)
#define PG8_LDA(dst, b, h) do { _Pragma("unroll") for (int m = 0; m < 4; ++m) { dst[m][0] = *(const LAS bf16x8*)(lds + PG8_SA(b, h) + aoff + m * 2048); \
        dst[m][1] = *(const LAS bf16x8*)(lds + PG8_SA(b, h) + (F8 ? aoff1 : aoff + 1024) + m * 2048); } } while (0)
#define PG8_LDB(dst, b, h) do { _Pragma("unroll") for (int n = 0; n < 2; ++n) { dst[n][0] = *(const LAS bf16x8*)(lds + PG8_SB(b, h) + boff + n * 2048); \
        dst[n][1] = *(const LAS bf16x8*)(lds + PG8_SB(b, h) + (F8 ? boff1 : boff + 1024) + n * 2048); } } while (0)
#define PG8_V8(X) __builtin_shufflevector(__builtin_bit_cast(i32x4_, X[0]), __builtin_bit_cast(i32x4_, X[1]), 0, 1, 2, 3, 4, 5, 6, 7)
#define PG8_MMA(ai, bj, At, Bt) do { if constexpr (F8) __builtin_amdgcn_sched_barrier(0); __builtin_amdgcn_s_setprio(1); _Pragma("unroll") for (int m = 0; m < 4; ++m) _Pragma("unroll") for (int n = 0; n < 2; ++n) { \
        if constexpr (F8) acc[ai][bj][m][n] = __builtin_amdgcn_mfma_scale_f32_16x16x128_f8f6f4(PG8_V8(Bt[n]), PG8_V8(At[m]), acc[ai][bj][m][n], 0, 0, 0, 0x7A7A7A7A, 0, 0x7F7F7F7F); \
        else { _Pragma("unroll") for (int k = 0; k < 2; ++k) acc[ai][bj][m][n] = __builtin_amdgcn_mfma_f32_16x16x32_bf16(Bt[n][k], At[m][k], acc[ai][bj][m][n], 0, 0, 0); } } \
        if constexpr (F8) __builtin_amdgcn_sched_barrier(0); __builtin_amdgcn_s_setprio(0); if constexpr (F8) __builtin_amdgcn_sched_barrier(0); } while (0)
#define PG8_WAIT_V(n) asm volatile("s_waitcnt vmcnt(" #n ")" ::: "memory")
#define PG8_WAIT_L(n) asm volatile("s_waitcnt lgkmcnt(" #n ")" ::: "memory")
#define PG8_BAR __builtin_amdgcn_s_barrier()
#define PG8_SCHED __builtin_amdgcn_sched_barrier(0)
    Unit cur, nxt; int ui = 0;
    if (!S.next(0, cur)) return;
    f32x4 acc[2][2][4][2];
#pragma unroll
    for (int a = 0; a < 2; ++a)
#pragma unroll
        for (int b = 0; b < 2; ++b)
#pragma unroll
            for (int m = 0; m < 4; ++m)
#pragma unroll
                for (int n = 0; n < 2; ++n) acc[a][b][m][n] = (f32x4){0.f, 0.f, 0.f, 0.f};
    bf16x8 At[4][2], B0[2][2], B1[2][2];
    unsigned cA = S.a_off(cur), cB = S.b_off(cur);
    if constexpr (SP2) {
        PG8_GFETCH(gC, 0);
        PG8_STAGE(PG8_SB(0, 0), rsB, cB, voffB); PG8_STAGE(PG8_SB(0, 1), rsB, cB + hB, voffB); PG8_STAGE_A(PG8_SA(0, 0), cA, 0, 0u); PG8_STAGE_A(PG8_SA(0, 1), cA + hA, 1, 0u);
        if (wr == 1) PG8_BAR;
        PG8_WAIT_V(2); PG8_BAR;
        PG8_STAGE(PG8_SB(1, 0), rsB, cB + kstep, voffB); PG8_STAGE_A(PG8_SA(1, 0), cA + kstep, 0, kstep); PG8_STAGE(PG8_SB(1, 1), rsB, cB + hB + kstep, voffB);
        PG8_WAIT_V(6); PG8_BAR;
    } else {
        PG8_STAGE(PG8_SB(0, 0), rsB, cB, voffB); PG8_STAGE(PG8_SA(0, 0), rsA, cA, voffA); PG8_STAGE(PG8_SB(0, 1), rsB, cB + hB, voffB); PG8_STAGE(PG8_SA(0, 1), rsA, cA + hA, voffA);
        if (wr == 1) PG8_BAR;
        PG8_WAIT_V(4); PG8_BAR;
        PG8_STAGE(PG8_SB(1, 0), rsB, cB + kstep, voffB); PG8_STAGE(PG8_SA(1, 0), rsA, cA + kstep, voffA); PG8_STAGE(PG8_SB(1, 1), rsB, cB + hB + kstep, voffB);
        PG8_WAIT_V(6); PG8_BAR;
    }
    for (;;) {
        const bool has_next = S.next(ui + 1, nxt);
        const unsigned nA = has_next ? S.a_off(nxt) : cA, nB = has_next ? S.b_off(nxt) : cB;
        PG8_GFETCH(gN, has_next ? ui + 1 : ui);
#pragma nounroll
        for (int t = 0; t < nt; t += 2) {
            const bool last = (t == nt - 2);
            const unsigned a1 = cA + (unsigned)(t + 1) * kstep;
            const unsigned a2 = last ? nA : cA + (unsigned)(t + 2) * kstep, b2 = last ? nB : cB + (unsigned)(t + 2) * kstep;
            const unsigned a3 = a2 + kstep, b3 = b2 + kstep;
            const unsigned k1 = (unsigned)(t + 1) * kstep, k2 = last ? 0u : (unsigned)(t + 2) * kstep, k3 = k2 + kstep;
            if constexpr (SP2) {
            PG8_LDB(B0, 0, 0); PG8_LDB(B1, 0, 1); PG8_SCHED; PG8_LDA(At, 0, 0); PG8_STAGE_A(PG8_SA(1, 1), a1 + hA, 1, k1);
            if constexpr (GA) { if (last) { gC[0][0] = gN[0][0]; gC[0][1] = gN[0][1]; gC[1][0] = gN[1][0]; gC[1][1] = gN[1][1]; } }
            PG8_WAIT_V(8); PG8_WAIT_L(0); PG8_BAR; PG8_MMA(0, 0, At, B0); PG8_MMA(0, 1, At, B1); PG8_BAR; PG8_SCHED;
            PG8_LDA(At, 0, 1); PG8_STAGE(PG8_SB(0, 0), rsB, b2, voffB); PG8_STAGE(PG8_SB(0, 1), rsB, b2 + hB, voffB); PG8_STAGE_A(PG8_SA(0, 0), a2, 0, k2);
            PG8_WAIT_V(8); PG8_WAIT_L(0); PG8_BAR; PG8_MMA(1, 0, At, B0); PG8_MMA(1, 1, At, B1); PG8_BAR; PG8_SCHED;
            PG8_LDB(B0, 1, 0); PG8_LDB(B1, 1, 1); PG8_SCHED; PG8_LDA(At, 1, 0); PG8_STAGE_A(PG8_SA(0, 1), a2 + hA, 1, k2);
            PG8_WAIT_V(8); PG8_WAIT_L(0); PG8_BAR; PG8_MMA(0, 0, At, B0); PG8_MMA(0, 1, At, B1); PG8_BAR; PG8_SCHED;
            PG8_LDA(At, 1, 1); PG8_STAGE(PG8_SB(1, 0), rsB, b3, voffB); PG8_STAGE(PG8_SB(1, 1), rsB, b3 + hB, voffB); PG8_STAGE_A(PG8_SA(1, 0), a3, 0, k3);
            PG8_WAIT_V(8); PG8_WAIT_L(0); PG8_BAR; PG8_MMA(1, 0, At, B0); PG8_MMA(1, 1, At, B1); PG8_BAR; PG8_SCHED;
            } else {
            PG8_LDB(B0, 0, 0); PG8_SCHED; PG8_LDA(At, 0, 0); PG8_STAGE(PG8_SA(1, 1), rsA, a1 + hA, voffA);
            PG8_WAIT_L(8); PG8_BAR; PG8_WAIT_L(0); PG8_MMA(0, 0, At, B0); PG8_BAR; PG8_SCHED;
            PG8_LDB(B1, 0, 1); PG8_STAGE(PG8_SB(0, 0), rsB, b2, voffB);
            PG8_BAR; PG8_WAIT_L(0); PG8_MMA(0, 1, At, B1); PG8_BAR;
            PG8_LDA(At, 0, 1); PG8_STAGE(PG8_SA(0, 0), rsA, a2, voffA);
            PG8_BAR; PG8_WAIT_L(0); PG8_MMA(1, 0, At, B0); PG8_BAR; PG8_SCHED;
            PG8_STAGE(PG8_SB(0, 1), rsB, b2 + hB, voffB);
            PG8_WAIT_V(6); PG8_BAR; PG8_MMA(1, 1, At, B1); PG8_BAR;
            PG8_LDB(B0, 1, 0); PG8_SCHED; PG8_LDA(At, 1, 0); PG8_STAGE(PG8_SA(0, 1), rsA, a2 + hA, voffA);
            PG8_WAIT_L(8); PG8_BAR; PG8_WAIT_L(0); PG8_MMA(0, 0, At, B0); PG8_BAR; PG8_SCHED;
            PG8_LDB(B1, 1, 1); PG8_STAGE(PG8_SB(1, 0), rsB, b3, voffB);
            PG8_BAR; PG8_WAIT_L(0); PG8_MMA(0, 1, At, B1); PG8_BAR;
            PG8_LDA(At, 1, 1); PG8_STAGE(PG8_SA(1, 0), rsA, a3, voffA);
            PG8_BAR; PG8_WAIT_L(0); PG8_MMA(1, 0, At, B0); PG8_BAR; PG8_SCHED;
            PG8_STAGE(PG8_SB(1, 1), rsB, b3 + hB, voffB);
            PG8_WAIT_V(6); PG8_BAR; PG8_MMA(1, 1, At, B1); PG8_BAR;
            }
        }
        if constexpr (ALIGN_EPI) { if (wr == 0) PG8_BAR; }
        for (int re_ = 0; re_ < (Epi::PROBE_REP ? RP_EPI : 1); ++re_) { asm volatile("" ::: "memory"); const int l2 = lane_id(); E(acc, cur, wr, wc, l2 & 15, l2 >> 4, scr); }
        if (!has_next) break;
#pragma unroll
        for (int a = 0; a < 2; ++a)
#pragma unroll
            for (int b = 0; b < 2; ++b)
#pragma unroll
                for (int m = 0; m < 4; ++m)
#pragma unroll
                    for (int n = 0; n < 2; ++n) acc[a][b][m][n] = (f32x4){0.f, 0.f, 0.f, 0.f};
        cur = nxt; cA = nA; cB = nB; ++ui;
        if constexpr (ALIGN_EPI) { if (wr == 1) PG8_BAR; }
    }
    PG8_WAIT_V(0);
    if constexpr (!ALIGN_EPI) { if (wr == 0) PG8_BAR; }
    PG8_BAR;
#undef PG8_SA
#undef PG8_SB
#undef PG8_STAGE
#undef PG8_STAGE_A
#undef PG8_GFETCH
#undef PG8_LDA
#undef PG8_LDB
#undef PG8_MMA
#undef PG8_V8
#undef PG8_WAIT_V
#undef PG8_WAIT_L
#undef PG8_BAR
#undef PG8_SCHED
}
}

struct Params { const float* in[31]; float* out; unsigned char* ws; int ph_lo, ph_hi; };
typedef const Params __attribute__((address_space(4)))* KP;
__device__ __forceinline__ KP kparams() { KP q = (KP)__builtin_amdgcn_kernarg_segment_ptr(); asm volatile("" : "+s"(q)); return q; }
enum { I_X = 0, I_C, I_CTX, I_CCTX, I_N1G, I_N2G, I_ADAW, I_ADAB, I_WIN, I_QNORM, I_WUQ, I_KVNORM, I_WUKV, I_QGAIN, I_KGAIN, I_SGUNORM, I_SGUW, I_SGUB,
       I_WGF, I_BGF, I_WGB, I_BGB, I_GLAON, I_WOUT, I_MWG, I_MBG, I_MWE, I_MBE, I_MW1, I_MW3, I_MW2 };

struct TileSched { static constexpr bool B_NT = false, GATHER = false;
    const char* A; const char* Bt; size_t a_tile, b_tile;
    int nM, nN, nwg, G, c, rep;
    __device__ __forceinline__ void init(const void* A_, size_t lda, const void* Bt_, size_t K, int nM_, int nN_, int G_, int c_, int rep_ = 1) {
        A = (const char*)A_; Bt = (const char*)Bt_; a_tile = 256 * lda * 2; b_tile = 256 * K * 2; nM = nM_; nN = nN_; nwg = nM * nN; G = G_; c = c_; rep = rep_; }
    __device__ __forceinline__ bool next(int i, pg8::Unit& u) const {
        const long L = (long)i * G + c; if (L >= (long)nwg * rep) return false;
        int wgid = (int)(L % nwg); { const int q = nwg / 8, r = nwg % 8, xcd = wgid % 8, off = wgid / 8; wgid = (xcd < r ? xcd * (q + 1) : r * (q + 1) + (xcd - r) * q) + off; }
        const int nig = 8 * nN, gid = wgid / nig, fm = gid * 8, gsz = (nM - fm) < 8 ? (nM - fm) : 8;
        u.pm = fm + ((wgid % nig) % gsz); u.pn = (wgid % nig) / gsz; u.aux = 0; return true;
    }
    __device__ __forceinline__ const char* a_base() const { return A; }
    __device__ __forceinline__ const char* b_base() const { return Bt; }
    __device__ __forceinline__ unsigned a_off(const pg8::Unit& u) const { return (unsigned)u.pm * (unsigned)a_tile; }
    __device__ __forceinline__ unsigned b_off(const pg8::Unit& u) const { return (unsigned)u.pn * (unsigned)b_tile; }
};
struct UpSched { static constexpr bool B_NT = false, GATHER = false;
    const char* Z; const char* Wq; const char* Wkv; int nQ, ntot, G, c, rep;
    __device__ __forceinline__ bool next(int i, pg8::Unit& u) const {
        int L = i * G + c; if (L >= ntot * rep) return false; L %= ntot;
        u.aux = (L >= nQ) ? 1 : 0; const int nk = u.aux ? ntot - nQ : nQ; if (u.aux) L -= nQ;
        if (L < (nk & ~255)) { const int i = L >> 8, c = L & 255, xcd = c & 7, j = c >> 3; u.pm = 32 * i + 4 * xcd + (j >> 3); u.pn = j & 7; }
        else { u.pm = L >> 3; u.pn = L & 7; }
        return true;
    }
    __device__ __forceinline__ const char* a_base() const { return Z; }
    __device__ __forceinline__ const char* b_base() const { return Wq; }
    __device__ __forceinline__ unsigned a_off(const pg8::Unit& u) const { return (unsigned)u.pm * (256u * DINP * 2u) + (u.aux ? ZC_CKV * 2u : ZC_CQ * 2u); }
    __device__ __forceinline__ unsigned b_off(const pg8::Unit& u) const { return (u.aux ? (unsigned)(Wkv - Wq) : 0u) + (unsigned)u.pn * (256u * 512u * 2u); }
};
struct MoeSched { static constexpr bool B_NT = (MOE_BNT != 0), GATHER = false;
    const char* A; const char* W; size_t a_tile, w_exp, b_tile; const volatile LAS int* tstart; int ntot, G, c, rep;
    __device__ __forceinline__ bool next(int i, pg8::Unit& u) const {
        int L = i * G + c; if (L >= ntot * rep) return false; L %= ntot;
        if (G == 256 && L < (ntot & ~255)) { const int r_ = L >> 8, cc = L & 255, x = cc & 7, j = cc >> 3; u.pn = 4 * (x & 1) + (j & 3); u.pm = 32 * r_ + 8 * (x >> 1) + (j >> 2); }
        else { u.pm = L >> 3; u.pn = L & 7; }
        int e = 0;
#pragma unroll
        for (int j = 1; j < 16; ++j) e += (u.pm >= tstart[j]) ? 1 : 0;
        u.aux = __builtin_amdgcn_readfirstlane(e); return true;
    }
    __device__ __forceinline__ const char* a_base() const { return A; }
    __device__ __forceinline__ const char* b_base() const { return W; }
    __device__ __forceinline__ unsigned a_off(const pg8::Unit& u) const { return (unsigned)u.pm * (unsigned)a_tile; }
    __device__ __forceinline__ unsigned b_off(const pg8::Unit& u) const { return (unsigned)u.aux * (unsigned)w_exp + (unsigned)u.pn * (unsigned)b_tile; }
};

struct MoeSchedG : MoeSched { static constexpr bool GATHER = true; const LAS unsigned* gtab; };

typedef const f32x4 (&AccRef)[2][2][4][2];
struct EpiZ { static constexpr bool PERM = true, PROBE_REP = false;
    bf16_t* Z; float* rsq;
    __device__ __forceinline__ void operator()(AccRef acc, const pg8::Unit& u, int wr, int wc, int fr, int fq, LAS unsigned char*) const {
        const int row0 = u.pm * 256 + wr * 64 + fr, col0 = u.pn * 256 + wc * 32 + 8 * fq;
#pragma unroll
        for (int ai = 0; ai < 2; ++ai)
#pragma unroll
            for (int m = 0; m < 4; ++m) { const int row = row0 + ai * 128 + m * 16; bf16_t* rowp = Z + (size_t)row * DINP + col0; float ss = 0.f;
#pragma unroll
                for (int bj = 0; bj < 2; ++bj) { const f32x4 v0 = acc[ai][bj][m][0], v1 = acc[ai][bj][m][1];
                    ss += (v0[0] * v0[0] + v0[1] * v0[1]) + (v0[2] * v0[2] + v0[3] * v0[3]) + (v1[0] * v1[0] + v1[1] * v1[1]) + (v1[2] * v1[2] + v1[3] * v1[3]);
                    u32x4 w; w.x = cvt_pk_bf16(v0[0], v0[1]); w.y = cvt_pk_bf16(v0[2], v0[3]); w.z = cvt_pk_bf16(v1[0], v1[1]); w.w = cvt_pk_bf16(v1[2], v1[3]);
                    *(u32x4*)(rowp + bj * 128) = w; }
                if (u.pn < 4) { ss += __shfl_xor(ss, 16); ss += __shfl_xor(ss, 32); if (fq == 0) rsq[(size_t)row * 16 + u.pn * 4 + wc] = ss; } }
    }
};
struct EpiBf16 { static constexpr bool PERM = true, PROBE_REP = false;
    bf16_t* O; int ldc;
    __device__ __forceinline__ void operator()(AccRef acc, const pg8::Unit& u, int wr, int wc, int fr, int fq, LAS unsigned char*) const {
        const int row0 = u.pm * 256 + wr * 64 + fr, col0 = u.pn * 256 + wc * 32 + 8 * fq;
#pragma unroll
        for (int ai = 0; ai < 2; ++ai)
#pragma unroll
            for (int m = 0; m < 4; ++m) { bf16_t* rowp = O + (size_t)(row0 + ai * 128 + m * 16) * ldc + col0;
#pragma unroll
                for (int bj = 0; bj < 2; ++bj) { const f32x4 v0 = acc[ai][bj][m][0], v1 = acc[ai][bj][m][1];
                    u32x4 w; w.x = cvt_pk_bf16(v0[0], v0[1]); w.y = cvt_pk_bf16(v0[2], v0[3]); w.z = cvt_pk_bf16(v1[0], v1[1]); w.w = cvt_pk_bf16(v1[2], v1[3]);
                    *(u32x4*)(rowp + bj * 128) = w; } }
    }
};
struct EpiSwiglu { static constexpr bool PERM = true, PROBE_REP = false;
    unsigned char* ACT;
    __device__ __forceinline__ void operator()(AccRef acc, const pg8::Unit& u, int wr, int wc, int fr, int fq, LAS unsigned char*) const {
        const int row0 = u.pm * 256 + wr * 64 + fr, col0 = u.pn * 128 + wc * 32 + 8 * fq;
#pragma unroll
        for (int ai = 0; ai < 2; ++ai)
#pragma unroll
            for (int m = 0; m < 4; ++m) { unsigned char* rowp = ACT + ((size_t)(row0 + ai * 128 + m * 16) * DEXP + col0) * (MOE_FP8 ? 1 : 2);
                float o[8];
#pragma unroll
                for (int n = 0; n < 2; ++n)
#pragma unroll
                    for (int v = 0; v < 4; ++v) { const float g = acc[ai][0][m][n][v], up = acc[ai][1][m][n][v]; o[n * 4 + v] = silu_f(g) * up; }
#if MOE_FP8
                u32x2 w; w.x = pk4_fp8(o[0], o[1], o[2], o[3]); w.y = pk4_fp8(o[4], o[5], o[6], o[7]);
                *(u32x2*)rowp = w; }
#else
                u32x4 w; w.x = cvt_pk_bf16(o[0], o[1]); w.y = cvt_pk_bf16(o[2], o[3]); w.z = cvt_pk_bf16(o[4], o[5]); w.w = cvt_pk_bf16(o[6], o[7]);
                *(u32x4*)rowp = w; }
#endif
    }
};
template <bool RB>
struct EpiResid { static constexpr bool PERM = true, PROBE_REP = false;
    const void* xlat; const void* xctx; const float* mod; bf16_t* X1;
    __device__ __forceinline__ void operator()(AccRef acc, const pg8::Unit& u, int wr, int wc, int fr, int fq, LAS unsigned char*) const {
        const int row0 = u.pm * 256 + wr * 64 + fr, col0 = u.pn * 256 + wc * 32 + 8 * fq;
        const float* __restrict__ gate = mod + (size_t)(u.pm < 64 ? (u.pm >> 4) : 4) * (6 * DM) + 2 * DM + col0;
        const size_t roff = (u.pm < 64 ? (size_t)row0 * DM : (size_t)(row0 - NLAT) * DM) + col0;
        const char* __restrict__ rbase = (const char*)(u.pm < 64 ? xlat : xctx) + roff * (RB ? 2 : 4);
        bf16_t* __restrict__ obase = X1 + (size_t)row0 * DM + col0;
        f32x4 gv[2][2];
#pragma unroll
        for (int bj = 0; bj < 2; ++bj)
#pragma unroll
            for (int n = 0; n < 2; ++n) gv[bj][n] = *(const f32x4*)(gate + bj * 128 + n * 4);
        f32x4 rA[2][2], rB[2][2];
#define ER_LOAD(R, g) do { const char* rp = rbase + (size_t)(((g) >> 2) * 128 + ((g) & 3) * 16) * DM * (RB ? 2 : 4); _Pragma("unroll") for (int bj = 0; bj < 2; ++bj) { \
            if constexpr (RB) { const u32x4 w = __builtin_nontemporal_load((const u32x4*)(rp + bj * 256)); R[bj][0] = (f32x4){bflo(w.x), bfhi(w.x), bflo(w.y), bfhi(w.y)}; R[bj][1] = (f32x4){bflo(w.z), bfhi(w.z), bflo(w.w), bfhi(w.w)}; } \
            else { R[bj][0] = __builtin_nontemporal_load((const f32x4*)(rp + bj * 512)); R[bj][1] = __builtin_nontemporal_load((const f32x4*)(rp + bj * 512 + 16)); } } } while (0)
#define ER_STORE(R, g) do { bf16_t* op = obase + (size_t)(((g) >> 2) * 128 + ((g) & 3) * 16) * DM; _Pragma("unroll") for (int bj = 0; bj < 2; ++bj) { \
            const f32x4 o0 = R[bj][0] + gv[bj][0] * acc[(g) >> 2][bj][(g) & 3][0], o1 = R[bj][1] + gv[bj][1] * acc[(g) >> 2][bj][(g) & 3][1]; \
            u32x4 w; w.x = cvt_pk_bf16(o0[0], o0[1]); w.y = cvt_pk_bf16(o0[2], o0[3]); w.z = cvt_pk_bf16(o1[0], o1[1]); w.w = cvt_pk_bf16(o1[2], o1[3]); *(u32x4*)(op + bj * 128) = w; } } while (0)
        ER_LOAD(rA, 0);
#pragma unroll
        for (int g = 0; g < 8; g += 2) { ER_LOAD(rB, g + 1); ER_STORE(rA, g); if (g + 2 < 8) ER_LOAD(rA, g + 2); ER_STORE(rB, g + 1); }
#undef ER_LOAD
#undef ER_STORE
    }
};
struct EpiUp { static constexpr bool PERM = false, PROBE_REP = true;
    const bf16_t* Z; const float* rsq; const float* qgain; const float* kgain; const f32x2* rope; bf16_t* Q; bf16_t* K; bf16_t* V;
    __device__ __forceinline__ void operator()(AccRef acc, const pg8::Unit& u, int wr, int wc, int fr, int fq, LAS unsigned char* scr) const {
        LAS float* part = (LAS float*)scr;
        const int kind = u.aux, head = u.pn;
        const int rl0 = wr * 64 + fr;
        const bool ropecols = (wc < 2);
        float rs[2][4];
        float ss[2][4];
#pragma unroll
        for (int ai = 0; ai < 2; ++ai)
#pragma unroll
            for (int m = 0; m < 4; ++m) { const int row = u.pm * 256 + rl0 + ai * 128 + m * 16;
                const f32x4* rp = (const f32x4*)(rsq + (size_t)row * 16 + (kind ? 8 : 0)); const f32x4 a = rp[0], b = rp[1];
                const float tot = ((a[0] + a[1]) + (a[2] + a[3])) + ((b[0] + b[1]) + (b[2] + b[3]));
                const float r = 1.0f / sqrtf(tot * (1.0f / 512.0f) + EPS); rs[ai][m] = r;
                float s = 0.f;
#pragma unroll
                for (int n = 0; n < 2; ++n) { const f32x4 v = acc[ai][0][m][n]; s += (v[0] * v[0] + v[1] * v[1]) + (v[2] * v[2] + v[3] * v[3]); }
                if (kind == 0) { if (ropecols) {
#pragma unroll
                        for (int n = 0; n < 2; ++n) { const f32x4 v = acc[ai][1][m][n]; s += (v[0] * v[0] + v[1] * v[1]) + (v[2] * v[2] + v[3] * v[3]); } }
                    s *= r * r;
                } else { s *= r * r;
                    if (ropecols) {
#pragma unroll
                        for (int n = 0; n < 2; ++n) { const u32x2 w = *(const u32x2*)(Z + (size_t)row * DINP + ZC_KPE + 32 * wc + 16 * n + 4 * fq);
                            const float x0 = bflo(w.x), x1 = bfhi(w.x), x2 = bflo(w.y), x3 = bfhi(w.y); s += (x0 * x0 + x1 * x1) + (x2 * x2 + x3 * x3); } } }
                s += __shfl_xor(s, 16); s += __shfl_xor(s, 32);
                if (fq == 0) part[(rl0 + ai * 128 + m * 16) * 4 + wc] = s; }
        asm volatile("s_waitcnt lgkmcnt(0)" ::: "memory"); __builtin_amdgcn_s_barrier(); asm volatile("" ::: "memory");
#pragma unroll
        for (int ai = 0; ai < 2; ++ai)
#pragma unroll
            for (int m = 0; m < 4; ++m) { const f32x4 p4 = *(const LAS f32x4*)(part + (rl0 + ai * 128 + m * 16) * 4);
                ss[ai][m] = 1.0f / sqrtf(((p4[0] + p4[1]) + (p4[2] + p4[3])) * (1.0f / 192.0f) + EPS); }
        const float* gain = kind ? kgain : qgain;
        f32x4 g0[2], g1[2];
#pragma unroll
        for (int n = 0; n < 2; ++n) { g0[n] = *(const f32x4*)(gain + 32 * wc + 16 * n + 4 * fq); g1[n] = ropecols ? *(const f32x4*)(gain + 128 + 32 * wc + 16 * n + 4 * fq) : (f32x4){0.f, 0.f, 0.f, 0.f}; }
        u32x2 kA[2], kB[2]; f32x2 cA[4], cB[4];
#define EU_LOAD(KX, CX, g) do { const int row_ = u.pm * 256 + rl0 + ((g) >> 2) * 128 + ((g) & 3) * 16; \
            if (kind && ropecols) { KX[0] = *(const u32x2*)(Z + (size_t)row_ * DINP + ZC_KPE + 32 * wc + 4 * fq); KX[1] = *(const u32x2*)(Z + (size_t)row_ * DINP + ZC_KPE + 32 * wc + 16 + 4 * fq); } \
            if (ropecols && row_ < NLAT) { const int t_ = row_ & (SEQ - 1); const int pos_ = (wc == 0) ? (t_ >> 6) : (t_ & 63); const f32x2* cs_ = rope + pos_ * 16 + 4 * fq; \
                _Pragma("unroll") for (int v = 0; v < 4; ++v) CX[v] = cs_[v]; } } while (0)
#define EU_STORE(KX, CX, g) do { const int ai = (g) >> 2, m = (g) & 3; const int row = u.pm * 256 + rl0 + ai * 128 + m * 16; const float sc = rs[ai][m] * ss[ai][m]; \
            bf16_t* qk = (kind ? K : Q) + (size_t)row * QLD + head * QKD; \
            _Pragma("unroll") for (int n = 0; n < 2; ++n) { const f32x4 v = acc[ai][0][m][n] * sc * g0[n]; u32x2 w; w.x = cvt_pk_bf16(v[0], v[1]); w.y = cvt_pk_bf16(v[2], v[3]); \
                *(u32x2*)(qk + 32 * wc + 16 * n + 4 * fq) = w; } \
            if (kind) { bf16_t* vp = V + (size_t)row * VLD + head * VD; \
                _Pragma("unroll") for (int n = 0; n < 2; ++n) { const f32x4 v = acc[ai][1][m][n] * rs[ai][m]; u32x2 w; w.x = cvt_pk_bf16(v[0], v[1]); w.y = cvt_pk_bf16(v[2], v[3]); \
                    *(u32x2*)(vp + 32 * wc + 16 * n + 4 * fq) = w; } } \
            if (ropecols) { f32x4 u1, u2; \
                if (kind == 0) { u1 = acc[ai][1][m][0] * sc * g1[0]; u2 = acc[ai][1][m][1] * sc * g1[1]; } \
                else { const u32x2 a = KX[0], b = KX[1]; const float s2 = ss[ai][m]; \
                    u1 = (f32x4){bflo(a.x), bfhi(a.x), bflo(a.y), bfhi(a.y)} * s2 * g1[0]; u2 = (f32x4){bflo(b.x), bfhi(b.x), bflo(b.y), bfhi(b.y)} * s2 * g1[1]; } \
                if (row < NLAT) { f32x4 o1, o2; \
                    _Pragma("unroll") for (int v = 0; v < 4; ++v) { const f32x2 c = CX[v]; o1[v] = u1[v] * c.x - u2[v] * c.y; o2[v] = u1[v] * c.y + u2[v] * c.x; } \
                    u1 = o1; u2 = o2; } \
                u32x2 w; w.x = cvt_pk_bf16(u1[0], u1[1]); w.y = cvt_pk_bf16(u1[2], u1[3]); *(u32x2*)(qk + 128 + 32 * wc + 4 * fq) = w; \
                w.x = cvt_pk_bf16(u2[0], u2[1]); w.y = cvt_pk_bf16(u2[2], u2[3]); *(u32x2*)(qk + 128 + 32 * wc + 16 + 4 * fq) = w; } } while (0)
        EU_LOAD(kA, cA, 0);
#pragma unroll
        for (int g = 0; g < 8; g += 2) { EU_LOAD(kB, cB, g + 1); EU_STORE(kA, cA, g); if (g + 2 < 8) EU_LOAD(kA, cA, g + 2); EU_STORE(kB, cB, g + 1); }
#undef EU_LOAD
#undef EU_STORE
    }
};

struct Frame {
    LAS unsigned char* lds; LAS unsigned char* scr; volatile LAS unsigned* MISC;
    int tid, lane, wave, G, bid;
    unsigned char* ws; unsigned* ctl;
};

__device__ __forceinline__ void tr_item(const float* W, int N, int k0, int n0, bf16_t* WT, int ldk, int dst_row0, const float* kscale, LAS unsigned* scr, int lane) {
    const int kq = lane >> 3, n4 = lane & 7;
    f32x4 v[8];
#pragma unroll
    for (int i = 0; i < 8; ++i) { const int k = k0 + 2 * kq + (i & 1) + 16 * (i >> 1); v[i] = *(const f32x4*)(W + (size_t)k * N + n0 + 4 * n4); }
    if (kscale) {
#pragma unroll
        for (int i = 0; i < 8; ++i) { const int k = k0 + 2 * kq + (i & 1) + 16 * (i >> 1); v[i] = v[i] * kscale[k]; } }
#pragma unroll
    for (int p = 0; p < 4; ++p)
#pragma unroll
        for (int j = 0; j < 4; ++j) scr[(4 * n4 + j) * 36 + kq + 8 * p] = pk2(v[2 * p][j], v[2 * p + 1][j]);
    LDS_WAIT(); asm volatile("" ::: "memory");
#pragma unroll
    for (int r = 0; r < 4; ++r) { const int nl = kq + 8 * r; const u32x4 o = *(const LAS u32x4*)(scr + nl * 36 + 4 * n4);
        *(u32x4*)(WT + (size_t)(dst_row0 + nl) * ldk + k0 + 8 * n4) = o; }
    LDS_WAIT(); asm volatile("" ::: "memory");
}

__device__ __forceinline__ void tr_item8(const float* W, int N, int k0, int n0, unsigned char* WT, int ldk, int dst_row0, LAS unsigned* scr, int lane) {
    const int kq = lane >> 3, n4 = lane & 7;
    f32x4 v[8];
#pragma unroll
    for (int i = 0; i < 8; ++i) { const int k = k0 + 4 * kq + (i & 3) + 32 * (i >> 2); v[i] = *(const f32x4*)(W + (size_t)k * N + n0 + 4 * n4) * W8_SCALE; }
#pragma unroll
    for (int q = 0; q < 2; ++q)
#pragma unroll
        for (int j = 0; j < 4; ++j) scr[(4 * n4 + j) * 20 + kq + 8 * q] = pk4_fp8(v[4 * q][j], v[4 * q + 1][j], v[4 * q + 2][j], v[4 * q + 3][j]);
    LDS_WAIT(); asm volatile("" ::: "memory");
#pragma unroll
    for (int r = 0; r < 2; ++r) { const int nl = (lane >> 2) + 16 * r, c = lane & 3; const u32x4 o = *(const LAS u32x4*)(scr + nl * 20 + 4 * c);
        *(u32x4*)(WT + (size_t)(dst_row0 + nl) * ldk + k0 + 16 * c) = o; }
    LDS_WAIT(); asm volatile("" ::: "memory");
}

namespace wt {
constexpr int KD8 = MOE_FP8 ? 2 : 1;
constexpr int I_IN = 32 * 115, I_UQ = 8 * 48, I_UKV = 8 * 64, I_OUT = 32 * 64 / (OUT_FP8 ? 2 : 1), I_W1 = 32 * 32 / KD8, I_W2 = 16 * 64 / KD8;
constexpr int NITEMS = I_IN + I_UQ + I_UKV + I_OUT + 16 * (2 * I_W1 + I_W2);
struct TrD { const float* W; unsigned char* WT; const float* ks; int N, k0, n0, ldk, row0, f8; };
__device__ __forceinline__ void decode(const int l, unsigned char* wb, int it, TrD& d) {
    int r = it; d.ks = nullptr; d.f8 = 0;
    if (r < I_IN) { const int kb = r / 115, nb = r % 115; d.W = kparams()->in[I_WIN] + (size_t)l * 2048 * DIN; d.N = DIN; d.k0 = kb * 64; d.n0 = nb * 32; d.WT = wb + W_IN; d.ldk = 2048 * 2; d.row0 = nb * 32; return; } r -= I_IN;
    if (r < I_UQ) { const int kb = r / 48, nb = r % 48, n0 = nb * 32; d.W = kparams()->in[I_WUQ] + (size_t)l * 512 * 1536; d.N = 1536; d.k0 = kb * 64; d.n0 = n0; d.WT = wb + W_UQ; d.ldk = 512 * 2; d.row0 = (n0 / 192) * 256 + (n0 % 192); d.ks = kparams()->in[I_QNORM] + l * 512; return; } r -= I_UQ;
    if (r < I_UKV) { const int kb = r / 64, nb = r % 64; d.W = kparams()->in[I_WUKV] + (size_t)l * 512 * 2048; d.N = 2048; d.k0 = kb * 64; d.n0 = nb * 32; d.WT = wb + W_UKV; d.ldk = 512 * 2; d.row0 = nb * 32; d.ks = kparams()->in[I_KVNORM] + l * 512; return; } r -= I_UKV;
    if (r < I_OUT) { const int kb = r / 64, nb = r % 64; d.W = kparams()->in[I_WOUT] + (size_t)l * 2048 * 2048; d.N = 2048; d.k0 = kb * 64 * (OUT_FP8 ? 2 : 1); d.n0 = nb * 32; d.WT = wb + W_OUT; d.ldk = 2048 * (OUT_FP8 ? 1 : 2); d.row0 = nb * 32; d.f8 = OUT_FP8; return; } r -= I_OUT;
    const int e = r / (2 * I_W1 + I_W2); r -= e * (2 * I_W1 + I_W2); d.f8 = MOE_FP8;
    if (r < 2 * I_W1) { const int which = r / I_W1; r -= which * I_W1; const int kb = r / 32, nb = r % 32, n0 = nb * 32;
        d.W = kparams()->in[which ? I_MW3 : I_MW1] + ((size_t)l * NEXP + e) * 2048 * 1024; d.N = 1024; d.k0 = kb * 64 * KD8; d.n0 = n0;
        d.WT = wb + W_GU + (size_t)e * 2048 * 2048 * (MOE_FP8 ? 1 : 2); d.ldk = 2048 * (MOE_FP8 ? 1 : 2); d.row0 = (n0 >> 7) * 256 + which * 128 + (n0 & 127); return; }
    r -= 2 * I_W1;
    { const int kb = r / 64, nb = r % 64; d.W = kparams()->in[I_MW2] + ((size_t)l * NEXP + e) * 1024 * 2048; d.N = 2048; d.k0 = kb * 64 * KD8; d.n0 = nb * 32;
      d.WT = wb + W_2 + (size_t)e * 2048 * 1024 * (MOE_FP8 ? 1 : 2); d.ldk = 1024 * (MOE_FP8 ? 1 : 2); d.row0 = nb * 32; }
}
}
#if W_NTS
#define W_ST(v, p) __builtin_nontemporal_store(v, p)
#else
#define W_ST(v, p) (*(p) = (v))
#endif
#if W_NT
#define W_LD(p) __builtin_nontemporal_load(p)
#else
#define W_LD(p) (*(p))
#endif
#define TR_LOAD(D, V) do { if ((D).f8) { _Pragma("unroll") for (int i = 0; i < 16; ++i) { const int k = (D).k0 + 4 * kq + (i & 3) + 32 * (i >> 2); V[i] = W_LD((const f32x4*)((D).W + (size_t)k * (D).N + (D).n0 + 4 * n4)); } } \
        else { _Pragma("unroll") for (int i = 0; i < 8; ++i) { const int k = (D).k0 + 2 * kq + (i & 1) + 16 * (i >> 1); V[i] = W_LD((const f32x4*)((D).W + (size_t)k * (D).N + (D).n0 + 4 * n4)); } } } while (0)
#define TR_STORE(D, V) do { \
        if ((D).f8) { \
            _Pragma("unroll") for (int q = 0; q < 4; ++q) _Pragma("unroll") for (int j = 0; j < 4; ++j) \
                scr[(4 * n4 + j) * 36 + kq + 8 * q] = pk4_fp8(V[4 * q][j] * W8_SCALE, V[4 * q + 1][j] * W8_SCALE, V[4 * q + 2][j] * W8_SCALE, V[4 * q + 3][j] * W8_SCALE); \
            LDS_WAIT(); asm volatile("" ::: "memory"); \
            _Pragma("unroll") for (int r = 0; r < 4; ++r) { const int nl = kq + 8 * r; const u32x4 o = *(const LAS u32x4*)(scr + nl * 36 + 4 * n4); \
                W_ST(o, (u32x4*)((D).WT + (size_t)((D).row0 + nl) * (D).ldk + (D).k0 + 16 * n4)); } \
        } else { \
            if ((D).ks) { _Pragma("unroll") for (int i = 0; i < 8; ++i) { const int k = (D).k0 + 2 * kq + (i & 1) + 16 * (i >> 1); V[i] = V[i] * (D).ks[k]; } } \
            _Pragma("unroll") for (int p = 0; p < 4; ++p) _Pragma("unroll") for (int j = 0; j < 4; ++j) scr[(4 * n4 + j) * 36 + kq + 8 * p] = pk2(V[2 * p][j], V[2 * p + 1][j]); \
            LDS_WAIT(); asm volatile("" ::: "memory"); \
            _Pragma("unroll") for (int r = 0; r < 4; ++r) { const int nl = kq + 8 * r; const u32x4 o = *(const LAS u32x4*)(scr + nl * 36 + 4 * n4); \
                *(u32x4*)((D).WT + (size_t)((D).row0 + nl) * (D).ldk + ((D).k0 + 8 * n4) * 2) = o; } \
        } \
        LDS_WAIT(); asm volatile("" ::: "memory"); } while (0)
#define WF_DECL() wt::TrD wfd; f32x4 wfv[16]; bool wfp = false
#define WF_LOAD(l1, done) do { const int it_ = F.bid * 8 + F.wave + F.G * 8 * (done); wfp = it_ < wt::NITEMS; \
        if (wfp) { wt::decode((l1), F.ws + WS_W + (size_t)(l1) * WL_BYTES, it_, wfd); TR_LOAD(wfd, wfv); } } while (0)
#define WF_STORE(done) do { if (wfp) { TR_STORE(wfd, wfv); ++(done); } } while (0)
__device__ __forceinline__ void phase_weights(const Frame& F, const int l, const int frac_lo, const int frac_hi, const int nblk, const int brank, const bool with_small, const int done0 = 0) {
    unsigned char* wb = F.ws + WS_W + (size_t)l * WL_BYTES;
    if (l == 0 && with_small) {
        LAS float* sc = (LAS float*)F.lds;
        LAS float* red = (LAS float*)(F.lds + 5 * 2048 * 4);
        for (int i = F.tid; i < 5 * 2048; i += 512) { const int r = i >> 11, k = i & 2047; const float x = (r < 4) ? kparams()->in[I_C][r * 2048 + k] : kparams()->in[I_CCTX][k]; sc[i] = silu_f(x); }
        __syncthreads();
#if ADA_KSPLIT
        for (int it = F.bid; it < 768; it += F.G) {
            const int kh = it / 384, rem = it % 384, ll = rem / 192, cg = rem % 192; const float* W = kparams()->in[I_ADAW] + (size_t)ll * 2048 * 12288 + cg * 64 + F.lane;
            float a0 = 0.f, a1 = 0.f, a2 = 0.f, a3 = 0.f, a4 = 0.f; const int kb = kh * 1024 + F.wave * 128;
            for (int k0 = 0; k0 < 128; k0 += 32) { float w[32];
#pragma unroll
                for (int k = 0; k < 32; ++k) w[k] = NT_LD(W + (size_t)(kb + k0 + k) * 12288);
#pragma unroll
                for (int k = 0; k < 32; ++k) { const int kk = kb + k0 + k; a0 += sc[kk] * w[k]; a1 += sc[2048 + kk] * w[k]; a2 += sc[4096 + kk] * w[k]; a3 += sc[6144 + kk] * w[k]; a4 += sc[8192 + kk] * w[k]; } }
            LAS float* rw = red + F.wave * 320; rw[F.lane] = a0; rw[64 + F.lane] = a1; rw[128 + F.lane] = a2; rw[192 + F.lane] = a3; rw[256 + F.lane] = a4;
            __syncthreads();
            if (F.tid < 320) { float s = 0.f;
#pragma unroll
                for (int w = 0; w < 8; ++w) s += red[w * 320 + F.tid];
                const int r = F.tid >> 6, col = cg * 64 + (F.tid & 63);
                if (kh == 0) s += kparams()->in[I_ADAB][ll * 12288 + col];
                __hip_atomic_fetch_add((float*)(F.ws + WS_MOD) + (size_t)(ll * 5 + r) * 12288 + col, s, __ATOMIC_RELAXED, __HIP_MEMORY_SCOPE_AGENT); }
            __syncthreads();
        }
#else
        for (int it_ = F.bid; it_ < 2 * 192 * RP_ADA; it_ += F.G) { const int it = it_ % 384;
            const int ll = it / 192, cg = it % 192; const float* W = kparams()->in[I_ADAW] + (size_t)ll * 2048 * 12288 + cg * 64 + F.lane;
            float a0 = 0.f, a1 = 0.f, a2 = 0.f, a3 = 0.f, a4 = 0.f; const int kb = F.wave * 256;
            for (int k0 = 0; k0 < 256; k0 += 32) { float w[32];
#pragma unroll
                for (int k = 0; k < 32; ++k) w[k] = NT_LD(W + (size_t)(kb + k0 + k) * 12288);
#pragma unroll
                for (int k = 0; k < 32; ++k) { const int kk = kb + k0 + k; a0 += sc[kk] * w[k]; a1 += sc[2048 + kk] * w[k]; a2 += sc[4096 + kk] * w[k]; a3 += sc[6144 + kk] * w[k]; a4 += sc[8192 + kk] * w[k]; } }
            LAS float* rw = red + F.wave * 320; rw[F.lane] = a0; rw[64 + F.lane] = a1; rw[128 + F.lane] = a2; rw[192 + F.lane] = a3; rw[256 + F.lane] = a4;
            __syncthreads();
            if (F.tid < 320) { float s = 0.f;
#pragma unroll
                for (int w = 0; w < 8; ++w) s += red[w * 320 + F.tid];
                const int r = F.tid >> 6, col = cg * 64 + (F.tid & 63);
                ((float*)(F.ws + WS_MOD))[(size_t)(ll * 5 + r) * 12288 + col] = s + kparams()->in[I_ADAB][ll * 12288 + col]; }
            __syncthreads();
        }
#endif
        if (F.bid == F.G - 1) { for (int i = F.tid; i < 64 * 16; i += 512) { const int pos = i >> 4, j = i & 15;
                const float inv = powf(10000.0f, -(float)j / 16.0f); const float ang = (float)pos * inv; float sn, cs; sincosf(ang, &sn, &cs);
                ((f32x2*)(F.ws + WS_ROPE))[i] = (f32x2){cs, sn}; } }
        __syncthreads();
    }
    LAS unsigned* scr = (LAS unsigned*)(F.lds + F.wave * 4608);
    const int gw = brank * 8 + F.wave, NGW = nblk * 8;
    const int kq = F.lane >> 3, n4 = F.lane & 7;
    { wt::TrD dA, dB; f32x4 vA[16], vB[16]; const int IT_LO = (int)((long)wt::NITEMS * frac_lo / 16), IT_HI = (int)((long)wt::NITEMS * frac_hi / 16); int it = IT_LO + gw + NGW * done0;
      if (it < IT_HI) { wt::decode(l, wb, it, dA); TR_LOAD(dA, vA); }
      while (it < IT_HI) {
          const int it1 = it + NGW; if (it1 < IT_HI) { wt::decode(l, wb, it1, dB); TR_LOAD(dB, vB); }
          TR_STORE(dA, vA);
          if (it1 >= IT_HI) break;
          const int it2 = it1 + NGW; if (it2 < IT_HI) { wt::decode(l, wb, it2, dA); TR_LOAD(dA, vA); }
          TR_STORE(dB, vB);
          it = it2; } }
    if (with_small) { const float* sw = kparams()->in[I_SGUW] + (size_t)l * 4 * 128 * 128; unsigned* dst = (unsigned*)(wb + W_SGU);
      for (int i = F.bid * 512 + F.tid; i < 4 * 128 * 128 / 2; i += F.G * 512) dst[i] = pk2(sw[2 * i], sw[2 * i + 1]); }
}

__device__ __forceinline__ void moe_table(const Frame& F, const int l, LAS int* tstart) {
    if (F.tid < 64) { unsigned* gcnt = F.ctl + CW_CNT + l * 64;
        const int c = (F.lane < 16) ? (int)__hip_atomic_load(gcnt + F.lane, __ATOMIC_RELAXED, __HIP_MEMORY_SCOPE_AGENT) : 0; const int t = (c + 255) >> 8; int incl = t;
#pragma unroll
        for (int k = 1; k < 16; k <<= 1) { const int v = __shfl_up(incl, k); if (F.lane >= k) incl += v; }
        if (F.lane < 16) { tstart[F.lane] = incl - t; tstart[32 + F.lane] = c; } if (F.lane == 15) tstart[16] = incl; }
    __syncthreads();
}
template <int MODE>
__device__ __forceinline__ void phase_rows(const Frame& F, const int l) {
    LAS float* gs = (LAS float*)F.lds;
    LAS float* sh = gs + 5 * 2048;
    LAS float* g2 = sh + 5 * 2048;
    const float* modl = (const float*)(F.ws + WS_MOD) + (size_t)(MODE == 2 ? 0 : l) * 5 * 12288;
    const float* modp = (const float*)(F.ws + WS_MOD) + (size_t)(MODE == 2 ? 1 : (l - 1)) * 5 * 12288;
    for (int i = F.tid; i < 5 * 2048; i += 512) { const int r = i >> 11, k = i & 2047;
        if (MODE != 2) { gs[i] = kparams()->in[I_N1G][l * 2048 + k] * (1.f + modl[r * 12288 + 2048 + k]); sh[i] = modl[r * 12288 + k]; }
        if (MODE != 0) g2[i] = modp[r * 12288 + 5 * 2048 + k]; }
    __syncthreads();
    const int gw = F.bid * 8 + F.wave, NGW = F.G * 8; const int nrows = (MODE == 2) ? NLAT : NTOK;
    const bf16_t* X1 = (const bf16_t*)(F.ws + WS_X1); bf16_t* X2 = (bf16_t*)(F.ws + WS_X2); bf16_t* H = (bf16_t*)(F.ws + WS_H);
    const bf16_t* Y = (const bf16_t*)(F.ws + WS_R + R_Y); const int* toks = (const int*)(F.ws + WS_TOKS); const float* cw = (const float*)(F.ws + WS_CW);
#if MOE_GATHER
    LAS int* tstart = (LAS int*)(F.scr + 8192); const int* toke = (const int*)(F.ws + WS_TOKE); const int* toki = (const int*)(F.ws + WS_TOKI);
    if (MODE != 0) moe_table(F, MODE == 2 ? DEPTH - 1 : l - 1, tstart);
#define SLOT_OF(row, k) (tstart[toke[(row) * 2 + (k)]] * 256 + toki[(row) * 2 + (k)])
#else
#define SLOT_OF(row, k) toks[(row) * 2 + (k)]
#endif
    struct RowRaw { f32x4 xf[8]; u32x2 xb[8], ya[8], yb[8]; float c0, c1; };
#define ROW_LOAD(R, row) do { \
        if (MODE == 0) { const float* src = ((row) < NLAT) ? kparams()->in[I_X] + (size_t)(row) * DM : kparams()->in[I_CTX] + (size_t)((row) - NLAT) * DM; \
            _Pragma("unroll") for (int i = 0; i < 8; ++i) R.xf[i] = NT_LD((const f32x4*)(src + 256 * i + 4 * F.lane)); } \
        else { const bf16_t* src = X1 + (size_t)(row) * DM; const int s0 = SLOT_OF(row, 0), s1 = SLOT_OF(row, 1); R.c0 = cw[(row) * 2]; R.c1 = cw[(row) * 2 + 1]; \
            const bf16_t* y0 = Y + (size_t)s0 * DM; const bf16_t* y1 = Y + (size_t)s1 * DM; \
            _Pragma("unroll") for (int i = 0; i < 8; ++i) { R.xb[i] = NT_LD((const u32x2*)(src + 256 * i + 4 * F.lane)); R.ya[i] = NT_LD((const u32x2*)(y0 + 256 * i + 4 * F.lane)); R.yb[i] = NT_LD((const u32x2*)(y1 + 256 * i + 4 * F.lane)); } } } while (0)
#define ROW_PROC(R, row) do { const int mr = mod_row_of(row); f32x4 v[8]; \
        if (MODE == 0) { _Pragma("unroll") for (int i = 0; i < 8; ++i) v[i] = R.xf[i]; } \
        else { \
            _Pragma("unroll") for (int i = 0; i < 8; ++i) { const u32x2 xw = R.xb[i], a = R.ya[i], b = R.yb[i]; \
                const f32x4 g = *(const LAS f32x4*)(g2 + mr * 2048 + 256 * i + 4 * F.lane); \
                const f32x4 x = (f32x4){bflo(xw.x), bfhi(xw.x), bflo(xw.y), bfhi(xw.y)}; \
                const f32x4 ya = (f32x4){bflo(a.x), bfhi(a.x), bflo(a.y), bfhi(a.y)}, yb = (f32x4){bflo(b.x), bfhi(b.x), bflo(b.y), bfhi(b.y)}; \
                v[i] = x + g * (ya * R.c0 + yb * R.c1); } \
            if (MODE == 2) { float* dst = kparams()->out + (size_t)(row) * DM; \
                _Pragma("unroll") for (int i = 0; i < 8; ++i) NT_ST(v[i], (f32x4*)(dst + 256 * i + 4 * F.lane)); \
            } else { bf16_t* dst = X2 + (size_t)(row) * DM; \
                _Pragma("unroll") for (int i = 0; i < 8; ++i) { u32x2 w; w.x = cvt_pk_bf16(v[i][0], v[i][1]); w.y = cvt_pk_bf16(v[i][2], v[i][3]); *(u32x2*)(dst + 256 * i + 4 * F.lane) = w; \
                    v[i] = (f32x4){bflo(w.x), bfhi(w.x), bflo(w.y), bfhi(w.y)}; } } \
        } \
        if (MODE != 2) { float s = 0.f; \
            _Pragma("unroll") for (int i = 0; i < 8; ++i) s += (v[i][0] * v[i][0] + v[i][1] * v[i][1]) + (v[i][2] * v[i][2] + v[i][3] * v[i][3]); \
            const float r = 1.0f / sqrtf(wave_sum(s) * (1.0f / DM) + EPS); \
            bf16_t* hp = H + (size_t)(row) * DM; \
            _Pragma("unroll") for (int i = 0; i < 8; ++i) { const f32x4 g = *(const LAS f32x4*)(gs + mr * 2048 + 256 * i + 4 * F.lane), b = *(const LAS f32x4*)(sh + mr * 2048 + 256 * i + 4 * F.lane); \
                const f32x4 o = v[i] * r * g + b; u32x2 w; w.x = cvt_pk_bf16(o[0], o[1]); w.y = cvt_pk_bf16(o[2], o[3]); *(u32x2*)(hp + 256 * i + 4 * F.lane) = w; } } } while (0)
    { RowRaw A, B; int row = gw;
      if (row < nrows) ROW_LOAD(A, row);
      while (row < nrows) {
          const int r1 = row + NGW; if (r1 < nrows) ROW_LOAD(B, r1);
          ROW_PROC(A, row);
          if (r1 >= nrows) break;
          const int r2 = r1 + NGW; if (r2 < nrows) ROW_LOAD(A, r2);
          ROW_PROC(B, r1);
          row = r2; } }
#undef ROW_LOAD
#undef SLOT_OF
#undef ROW_PROC
}


namespace attn {
constexpr int KVBLK = 64, QBLK = 32;
constexpr float SCALE = 0.07216878364870322f;
constexpr float THR = 8.f;
constexpr int SHM_V = KVBLK * VD * 2, SHM_KN = KVBLK * NOPE * 2, SHM_KP = KVBLK * ROPE * 2;
constexpr int NBUF = ATTN_NBUF;
constexpr int OFF_V = 0, OFF_KN = NBUF * SHM_V, OFF_KP = OFF_KN + NBUF * SHM_KN, OFF_WS = OFF_KP + NBUF * SHM_KP, OFF_QP = OFF_WS + 8 * 64 * 4, LDS_ATTN = OFF_QP + 8 * 4 * 64 * 16;
static_assert(LDS_ATTN <= MISC_OFF, "attention LDS");
#define KSWZ(row, colB) ((row) * 256 + ((colB) ^ (((row) & 7) << 4)))
#define PSWZ(row, colB) ((row) * 128 + ((colB) ^ (((row) & 7) << 4)))
#define SBAR() __builtin_amdgcn_sched_barrier(0)
__device__ __forceinline__ int crow(int r, int hi) { return (r & 3) + 8 * (r >> 2) + 4 * hi; }
__device__ __forceinline__ unsigned cvtpk(float lo, float hi) { unsigned r; asm("v_cvt_pk_bf16_f32 %0, %1, %2" : "=v"(r) : "v"(lo), "v"(hi)); return r; }

__device__ __forceinline__ void partialSM(f32x16& p0, f32x16& p1, float& m_reg, float& mn, float& alpha) {
  constexpr float C = SCALE * 1.4426950408889634f;
  float pmax = p0[0];
#pragma unroll
  for (int r = 1; r < 16; ++r) pmax = fmaxf(pmax, p0[r]);
#pragma unroll
  for (int r = 0; r < 16; ++r) pmax = fmaxf(pmax, p1[r]);
  { auto rr = __builtin_amdgcn_permlane32_swap(__float_as_uint(pmax), __float_as_uint(pmax), false, false);
    pmax = fmaxf(__uint_as_float(rr[0]), __uint_as_float(rr[1])); }
  if (__builtin_expect(__all(pmax - m_reg <= THR / SCALE), 1)) { mn = m_reg; alpha = 1.f; }
  else { mn = fmaxf(m_reg, pmax); alpha = __builtin_amdgcn_exp2f((m_reg - mn) * C); m_reg = mn; }
  float mnC = -mn * C;
#pragma unroll
  for (int r = 0; r < 16; ++r) p0[r] = fmaf(p0[r], C, mnC);
#pragma unroll
  for (int r = 0; r < 16; ++r) p1[r] = fmaf(p1[r], C, mnC);
#pragma unroll
  for (int r = 0; r < 16; ++r) p0[r] = __builtin_amdgcn_exp2f(p0[r]);
}
__device__ __forceinline__ void finishSM(f32x16& p0, f32x16& p1, float alpha, float& l_reg, bf16x8& pa0, bf16x8& pa1, bf16x8& pa2, bf16x8& pa3) {
#pragma unroll
  for (int r = 0; r < 16; ++r) p1[r] = __builtin_amdgcn_exp2f(p1[r]);
  float ps = 0;
#pragma unroll
  for (int r = 0; r < 16; ++r) ps += p0[r];
#pragma unroll
  for (int r = 0; r < 16; ++r) ps += p1[r];
  { auto rr = __builtin_amdgcn_permlane32_swap(__float_as_uint(ps), __float_as_uint(ps), false, false);
    ps = __uint_as_float(rr[0]) + __uint_as_float(rr[1]); }
  l_reg = l_reg * alpha + ps;
#define PK4(P, BASE, OUT) do { unsigned a0 = cvtpk(P[BASE + 0], P[BASE + 1]), a1 = cvtpk(P[BASE + 2], P[BASE + 3]);   \
    unsigned b0 = cvtpk(P[BASE + 4], P[BASE + 5]), b1 = cvtpk(P[BASE + 6], P[BASE + 7]);                              \
    auto r0 = __builtin_amdgcn_permlane32_swap(a0, b0, false, false); auto r1 = __builtin_amdgcn_permlane32_swap(a1, b1, false, false); \
    u32x4 w = {r0[0], r1[0], r0[1], r1[1]}; OUT = *reinterpret_cast<bf16x8*>(&w); } while (0)
  PK4(p0, 0, pa0); PK4(p0, 8, pa1); PK4(p1, 0, pa2); PK4(p1, 8, pa3);
#undef PK4
}
__device__ __forceinline__ void qkt(f32x16& p0, f32x16& p1, const char* Kn, const char* Kp, const bf16x8* qr, const char* qp, int r32, int hi) {
  p0 = f32x16{}; p1 = f32x16{};
#pragma unroll
  for (int d0 = 0; d0 < 8; ++d0) { const int cb = (d0 * 16 + hi * 8) * 2;
    bf16x8 b0 = *reinterpret_cast<const bf16x8*>(Kn + KSWZ(r32, cb));
    bf16x8 b1 = *reinterpret_cast<const bf16x8*>(Kn + KSWZ(32 + r32, cb));
    p0 = __builtin_amdgcn_mfma_f32_32x32x16_bf16(b0, qr[d0], p0, 0, 0, 0);
    p1 = __builtin_amdgcn_mfma_f32_32x32x16_bf16(b1, qr[d0], p1, 0, 0, 0); }
#pragma unroll
  for (int d0 = 0; d0 < 4; ++d0) { const int cb = (d0 * 16 + hi * 8) * 2;
    bf16x8 b0 = *reinterpret_cast<const bf16x8*>(Kp + PSWZ(r32, cb));
    bf16x8 b1 = *reinterpret_cast<const bf16x8*>(Kp + PSWZ(32 + r32, cb));
    const bf16x8 qf = *reinterpret_cast<const bf16x8*>(qp + d0 * 1024);
    p0 = __builtin_amdgcn_mfma_f32_32x32x16_bf16(b0, qf, p0, 0, 0, 0);
    p1 = __builtin_amdgcn_mfma_f32_32x32x16_bf16(b1, qf, p1, 0, 0, 0); }
}
__device__ __forceinline__ int v_st(int k, int c) { const int kk = (k & ~0xC) | ((k & 4) << 1) | ((k & 8) >> 1); return ((kk >> 3) * 4 + (c >> 5)) * 512 + ((kk & 7) * 32 + (c & 31)) * 2; }
__device__ __forceinline__ int v_rd_base(int lane) { return ((lane & 3) << 3) | (((lane >> 2) & 3) << 6) | (((lane >> 4) & 1) << 5) | (((lane >> 5) & 1) << 8); }
constexpr int v_rd_off(int d0, int ks, int half) { return d0 * 512 + ks * 4096 + half * 2048; }
template <int OFF> __device__ __forceinline__ s16x4 tr_read(int vb) {
  s16x4 r; asm volatile("ds_read_b64_tr_b16 %0, %1 offset:%2" : "=&v"(r) : "v"(vb), "i"(OFF) : "memory"); return r;
}
template <int D0> __device__ __forceinline__ void pv_one(f32x16& od, int vb, bf16x8 pa0, bf16x8 pa1, bf16x8 pa2, bf16x8 pa3) {
  const s16x4 l0 = tr_read<v_rd_off(D0, 0, 0)>(vb), h0 = tr_read<v_rd_off(D0, 0, 1)>(vb), l1 = tr_read<v_rd_off(D0, 1, 0)>(vb), h1 = tr_read<v_rd_off(D0, 1, 1)>(vb);
  const s16x4 l2 = tr_read<v_rd_off(D0, 2, 0)>(vb), h2 = tr_read<v_rd_off(D0, 2, 1)>(vb), l3 = tr_read<v_rd_off(D0, 3, 0)>(vb), h3 = tr_read<v_rd_off(D0, 3, 1)>(vb);
  asm volatile("s_waitcnt lgkmcnt(0)" ::: "memory"); SBAR();
#define PK(L, H) (bf16x8){L[0], L[1], L[2], L[3], H[0], H[1], H[2], H[3]}
  od = __builtin_amdgcn_mfma_f32_32x32x16_bf16(pa0, PK(l0, h0), od, 0, 0, 0);
  od = __builtin_amdgcn_mfma_f32_32x32x16_bf16(pa1, PK(l1, h1), od, 0, 0, 0);
  od = __builtin_amdgcn_mfma_f32_32x32x16_bf16(pa2, PK(l2, h2), od, 0, 0, 0);
  od = __builtin_amdgcn_mfma_f32_32x32x16_bf16(pa3, PK(l3, h3), od, 0, 0, 0);
#undef PK
}
__device__ __forceinline__ void pv_d0(f32x16* o, int vb, bf16x8 pa0, bf16x8 pa1, bf16x8 pa2, bf16x8 pa3) {
  pv_one<0>(o[0], vb, pa0, pa1, pa2, pa3); pv_one<1>(o[1], vb, pa0, pa1, pa2, pa3); pv_one<2>(o[2], vb, pa0, pa1, pa2, pa3); pv_one<3>(o[3], vb, pa0, pa1, pa2, pa3);
}

__device__ __forceinline__ void pv_sm(f32x16* o, int vb, bf16x8 pa0, bf16x8 pa1, bf16x8 pa2, bf16x8 pa3, f32x16& p0, f32x16& p1, float& m_reg, float& mn, float& alpha) {
  constexpr float C = SCALE * 1.4426950408889634f;
#define PV_READS(D0) const s16x4 l0 = tr_read<v_rd_off(D0, 0, 0)>(vb), h0 = tr_read<v_rd_off(D0, 0, 1)>(vb), l1 = tr_read<v_rd_off(D0, 1, 0)>(vb), h1 = tr_read<v_rd_off(D0, 1, 1)>(vb); \
  const s16x4 l2 = tr_read<v_rd_off(D0, 2, 0)>(vb), h2 = tr_read<v_rd_off(D0, 2, 1)>(vb), l3 = tr_read<v_rd_off(D0, 3, 0)>(vb), h3 = tr_read<v_rd_off(D0, 3, 1)>(vb); \
  asm volatile("s_waitcnt lgkmcnt(0)" ::: "memory"); SBAR();
#define PK(L, H) (bf16x8){L[0], L[1], L[2], L[3], H[0], H[1], H[2], H[3]}
#define PV_MMA(D0) o[D0] = __builtin_amdgcn_mfma_f32_32x32x16_bf16(pa0, PK(l0, h0), o[D0], 0, 0, 0); o[D0] = __builtin_amdgcn_mfma_f32_32x32x16_bf16(pa1, PK(l1, h1), o[D0], 0, 0, 0); \
  o[D0] = __builtin_amdgcn_mfma_f32_32x32x16_bf16(pa2, PK(l2, h2), o[D0], 0, 0, 0); o[D0] = __builtin_amdgcn_mfma_f32_32x32x16_bf16(pa3, PK(l3, h3), o[D0], 0, 0, 0);
  float pmax;
  { PV_READS(0)
    pmax = p0[0];
#pragma unroll
    for (int r = 1; r < 16; ++r) pmax = fmaxf(pmax, p0[r]);
    PV_MMA(0) }
  float mnC;
  { PV_READS(1)
#pragma unroll
    for (int r = 0; r < 16; ++r) pmax = fmaxf(pmax, p1[r]);
    { auto rr = __builtin_amdgcn_permlane32_swap(__float_as_uint(pmax), __float_as_uint(pmax), false, false); pmax = fmaxf(__uint_as_float(rr[0]), __uint_as_float(rr[1])); }
    if (__builtin_expect(__all(pmax - m_reg <= THR / SCALE), 1)) { mn = m_reg; alpha = 1.f; }
    else { mn = fmaxf(m_reg, pmax); alpha = __builtin_amdgcn_exp2f((m_reg - mn) * C); m_reg = mn; }
    mnC = -mn * C;
    PV_MMA(1) }
  { PV_READS(2)
#pragma unroll
    for (int r = 0; r < 16; ++r) p0[r] = fmaf(p0[r], C, mnC);
#pragma unroll
    for (int r = 0; r < 16; ++r) p1[r] = fmaf(p1[r], C, mnC);
    PV_MMA(2) }
  { PV_READS(3)
#pragma unroll
    for (int r = 0; r < 16; ++r) p0[r] = __builtin_amdgcn_exp2f(p0[r]);
    PV_MMA(3) }
#undef PV_READS
#undef PV_MMA
#undef PK
}

__device__ __forceinline__ void attn_body(const int tid, const bf16_t* __restrict__ Qb, const bf16_t* __restrict__ Kh, const bf16_t* __restrict__ Vh, MixT* __restrict__ Ob,
                                          const int rowA, const int nA, const int rowB, const int NT, char* lds) {
  const int wid = __builtin_amdgcn_readfirstlane(tid >> 6), lane = tid & 63, r32 = lane & 31, hi = lane >> 5;
  char* V_lds = lds + OFF_V; char* Kn_lds = lds + OFF_KN; char* Kp_lds = lds + OFF_KP;
  float* ws = (float*)(lds + OFF_WS) + wid * 64; float* li_l = ws; float* al_l = ws + 32;
  float m_reg = -1e30f, l_reg = 0; f32x16 o[4] = {}; bf16x8 qr[8];
  const bf16_t* Qw = Qb + (long)(wid * QBLK + r32) * QLD + hi * 8;
#pragma unroll
  for (int d0 = 0; d0 < 8; ++d0) qr[d0] = *reinterpret_cast<const bf16x8*>(Qw + d0 * 16);
  char* qp = lds + OFF_QP + wid * 4096 + lane * 16;
#pragma unroll
  for (int d0 = 0; d0 < 4; ++d0) *reinterpret_cast<bf16x8*>(qp + d0 * 1024) = *reinterpret_cast<const bf16x8*>(Qw + (8 + d0) * 16);
  const int sr = tid >> 4, sc = (tid & 15) * 8, vst0 = v_st(sr, sc), vst1 = v_st(32 + sr, sc);
  const int kr = tid >> 3, kc = (tid & 7) * 8;
  const int vb0 = (int)(uintptr_t)V_lds + v_rd_base(lane);
  bf16x8 vs0, vs1, ks0, ks1, kp0;
#define TROW(j) ((j) < nA ? rowA + 64 * (j) : rowB + 64 * ((j) - nA))
#define SLOAD(j) do { const long _t0 = TROW(j); \
    vs0 = *reinterpret_cast<const bf16x8*>(&Vh[(_t0 + sr) * VLD + sc]); vs1 = *reinterpret_cast<const bf16x8*>(&Vh[(_t0 + 32 + sr) * VLD + sc]); \
    ks0 = *reinterpret_cast<const bf16x8*>(&Kh[(_t0 + sr) * QLD + sc]); ks1 = *reinterpret_cast<const bf16x8*>(&Kh[(_t0 + 32 + sr) * QLD + sc]); \
    kp0 = *reinterpret_cast<const bf16x8*>(&Kh[(_t0 + kr) * QLD + NOPE + kc]); } while (0)
#define SWRITE(b) do { *(bf16x8*)(V_lds + (b) * SHM_V + vst0) = vs0; *(bf16x8*)(V_lds + (b) * SHM_V + vst1) = vs1; \
    *(bf16x8*)(Kn_lds + (b) * SHM_KN + KSWZ(sr, sc * 2)) = ks0; *(bf16x8*)(Kn_lds + (b) * SHM_KN + KSWZ(32 + sr, sc * 2)) = ks1; \
    *(bf16x8*)(Kp_lds + (b) * SHM_KP + PSWZ(kr, kc * 2)) = kp0; } while (0)
#define SWAIT() asm volatile("s_waitcnt vmcnt(0)" ::: "memory")
#define RESC(a) do { if (__any((a) < 1.f)) { if (hi == 0) al_l[r32] = (a); asm volatile("s_waitcnt lgkmcnt(0)" ::: "memory"); \
    _Pragma("unroll") for (int d = 0; d < 4; ++d) _Pragma("unroll") for (int r = 0; r < 16; ++r) o[d][r] *= al_l[crow(r, hi)]; } } while (0)
  f32x16 pA0, pA1, pB0, pB1; float mnA, mnB, alA, alB; bf16x8 pa0, pa1, pa2, pa3;
#if ATTN_NBUF == 3
#define SWRITE_R(ob) do { *(bf16x8*)(V_lds + (ob) + vst0) = vs0; *(bf16x8*)(V_lds + (ob) + vst1) = vs1; \
    *(bf16x8*)(Kn_lds + (ob) + KSWZ(sr, sc * 2)) = ks0; *(bf16x8*)(Kn_lds + (ob) + KSWZ(32 + sr, sc * 2)) = ks1; \
    *(bf16x8*)(Kp_lds + ((ob) >> 1) + PSWZ(kr, kc * 2)) = kp0; } while (0)
#define ROT() do { ov = oq; oq = ow; ow = (ow == 2 * (int)SHM_V) ? 0 : ow + (int)SHM_V; } while (0)
  static_assert(SHM_V == SHM_KN && SHM_KP * 2 == SHM_V, "ring offsets");
  SLOAD(0); SWAIT(); SWRITE_R(0); SLOAD(1); __syncthreads();
  qkt(pA0, pA1, Kn_lds, Kp_lds, qr, qp, r32, hi); partialSM(pA0, pA1, m_reg, mnA, alA);
  SWAIT(); SWRITE_R((int)SHM_V); SLOAD(2); __syncthreads();
  int oq = (int)SHM_V, ov = 0, ow = 2 * (int)SHM_V;
  for (int j = 1; j + 1 < NT; j += 2) {
    SBAR(); qkt(pB0, pB1, Kn_lds + oq, Kp_lds + (oq >> 1), qr, qp, r32, hi);
    finishSM(pA0, pA1, alA, l_reg, pa0, pa1, pa2, pa3); SBAR();
    pv_sm(o, vb0 + ov, pa0, pa1, pa2, pa3, pB0, pB1, m_reg, mnB, alB);
    SWAIT(); SWRITE_R(ow); SLOAD(j + 2); SBAR();
    RESC(alB); __syncthreads(); ROT();
    SBAR(); qkt(pA0, pA1, Kn_lds + oq, Kp_lds + (oq >> 1), qr, qp, r32, hi);
    finishSM(pB0, pB1, alB, l_reg, pa0, pa1, pa2, pa3); SBAR();
    pv_sm(o, vb0 + ov, pa0, pa1, pa2, pa3, pA0, pA1, m_reg, mnA, alA);
    SWAIT(); SWRITE_R(ow); if (j + 3 < NT) SLOAD(j + 3); SBAR();
    RESC(alA); __syncthreads(); ROT();
  }
  SBAR(); qkt(pB0, pB1, Kn_lds + oq, Kp_lds + (oq >> 1), qr, qp, r32, hi);
  finishSM(pA0, pA1, alA, l_reg, pa0, pa1, pa2, pa3); SBAR();
  pv_sm(o, vb0 + ov, pa0, pa1, pa2, pa3, pB0, pB1, m_reg, mnB, alB);
  RESC(alB);
  finishSM(pB0, pB1, alB, l_reg, pa0, pa1, pa2, pa3); SBAR();
  pv_d0(o, vb0 + oq, pa0, pa1, pa2, pa3);
#undef SWRITE_R
#undef ROT
#else
  SLOAD(0); SWAIT(); SWRITE(0); __syncthreads();
  qkt(pA0, pA1, Kn_lds, Kp_lds, qr, qp, r32, hi); partialSM(pA0, pA1, m_reg, mnA, alA);
  SLOAD(1);
  SWAIT(); SWRITE(1); __syncthreads();
  for (int j = 1; j + 1 < NT; j += 2) {
    SBAR(); qkt(pB0, pB1, Kn_lds + SHM_KN, Kp_lds + SHM_KP, qr, qp, r32, hi);
    finishSM(pA0, pA1, alA, l_reg, pa0, pa1, pa2, pa3); SBAR();
    SLOAD(j + 1); SBAR();
    pv_sm(o, vb0, pa0, pa1, pa2, pa3, pB0, pB1, m_reg, mnB, alB);
    __syncthreads(); SWAIT(); SWRITE(0);
    RESC(alB); __syncthreads();
    SBAR(); qkt(pA0, pA1, Kn_lds, Kp_lds, qr, qp, r32, hi);
    finishSM(pB0, pB1, alB, l_reg, pa0, pa1, pa2, pa3); SBAR();
    SLOAD(j + 2); SBAR();
    pv_sm(o, vb0 + (int)SHM_V, pa0, pa1, pa2, pa3, pA0, pA1, m_reg, mnA, alA);
    __syncthreads(); SWAIT(); SWRITE(1);
    RESC(alA); __syncthreads();
  }
  SBAR(); qkt(pB0, pB1, Kn_lds + SHM_KN, Kp_lds + SHM_KP, qr, qp, r32, hi);
  finishSM(pA0, pA1, alA, l_reg, pa0, pa1, pa2, pa3); SBAR();
  pv_sm(o, vb0, pa0, pa1, pa2, pa3, pB0, pB1, m_reg, mnB, alB);
  __syncthreads(); RESC(alB);
  finishSM(pB0, pB1, alB, l_reg, pa0, pa1, pa2, pa3); SBAR();
  pv_d0(o, vb0 + (int)SHM_V, pa0, pa1, pa2, pa3);
#endif
  if (hi == 0) li_l[r32] = l_reg; asm volatile("s_waitcnt lgkmcnt(0)" ::: "memory");
  float rli[16];
#pragma unroll
  for (int r = 0; r < 16; ++r) rli[r] = __builtin_amdgcn_rcpf(li_l[crow(r, hi)]);
  { int t2 = tid; asm volatile("" : "+v"(t2));
    const int w2 = __builtin_amdgcn_readfirstlane(t2 >> 6), c2 = t2 & 31, h2 = (t2 >> 5) & 1;
    MixT* Ow = Ob + (long)(w2 * QBLK) * DM + c2;
#pragma unroll
    for (int r = 0; r < 16; ++r) { const int orow = crow(r, h2);
#pragma unroll
      for (int d0 = 0; d0 < 4; d0 += 2) {
#if OUT_FP8
        const unsigned w = pk2_fp8(o[d0][r] * rli[r], o[d0 + 1][r] * rli[r]);
        Ow[(long)orow * DM + d0 * 32] = (unsigned char)(w & 0xFF); Ow[(long)orow * DM + d0 * 32 + 32] = (unsigned char)(w >> 8);
#else
Ow[(long)orow * DM + d0 * 32] = (bf16_t)f2bf(o[d0][r] * rli[r]); Ow[(long)orow * DM + d0 * 32 + 32] = (bf16_t)f2bf(o[d0 + 1][r] * rli[r]);
#endif
      } } }
  __syncthreads();
#undef TROW
#undef SLOAD
#undef SWRITE
#undef SWAIT
#undef RESC
}
#undef KSWZ
#undef PSWZ
#undef SBAR
}

template <int KS>
__device__ __forceinline__ f32x16 mma32(const LAS bf16_t* A, int lda, const LAS bf16_t* Bt, int ldb, f32x16 acc, int lane) {
    const int r = lane & 31, h = lane >> 5;
#pragma unroll
    for (int ks = 0; ks < KS; ++ks) {
        const bf16x8 a = *(const LAS bf16x8*)(A + r * lda + ks * 16 + 8 * h);
        const bf16x8 b = *(const LAS bf16x8*)(Bt + r * ldb + ks * 16 + 8 * h);
        acc = __builtin_amdgcn_mfma_f32_32x32x16_bf16(a, b, acc, 0, 0, 0); }
    return acc;
}
__device__ __forceinline__ int crow32(int v, int h) { return (v & 3) + 8 * (v >> 2) + 4 * h; }

struct UnitQ { int a, b; };
__device__ __forceinline__ void q_first(const Frame& F, unsigned* ctr, UnitQ& q) { q.a = 0; q.b = 0;
    if (F.tid == 0) { q.a = (int)__hip_atomic_fetch_add(ctr, 1u, __ATOMIC_RELAXED, __HIP_MEMORY_SCOPE_AGENT); q.b = (int)__hip_atomic_fetch_add(ctr, 1u, __ATOMIC_RELAXED, __HIP_MEMORY_SCOPE_AGENT); } }
__device__ __forceinline__ void q_next(const Frame& F, unsigned* ctr, UnitQ& q, int& cur, int& nxt) {
    lds_barrier();
    if (F.tid == 0) { F.MISC[16] = (unsigned)q.a; F.MISC[17] = (unsigned)q.b; q.a = q.b; q.b = (int)__hip_atomic_fetch_add(ctr, 1u, __ATOMIC_RELAXED, __HIP_MEMORY_SCOPE_AGENT); }
    lds_barrier();
    cur = (int)F.MISC[16]; nxt = (int)F.MISC[17];
}

constexpr int SGU_LD = 136;
__device__ __forceinline__ void sgu_unit(const Frame& F, const int l, const int un) {
    LAS bf16_t* Wl = (LAS bf16_t*)F.lds;
    LAS bf16_t* Vt = Wl + 128 * SGU_LD;
    const bf16_t* Z = (const bf16_t*)(F.ws + WS_R + R_Z); MixT* MIX = (MixT*)(F.ws + WS_R + R_MIX);
    const bf16_t* Wg = (const bf16_t*)(F.ws + WS_W + (size_t)l * WL_BYTES + W_SGU);
    const float* vgain = kparams()->in[I_SGUNORM] + l * 512; const float* bs = kparams()->in[I_SGUB] + l * 512;
    const int ch = un >> 2, g = un & 3; const int row0 = (ch < 128) ? ch * 128 : NLAT + (ch - 128) * 128;
    for (int i = F.tid; i < 2048; i += 512) { const int t = i >> 4, c = i & 15; *(LAS u32x4*)(Wl + t * SGU_LD + c * 8) = *(const u32x4*)(Wg + (size_t)g * 16384 + t * 128 + c * 8); }
    { const int s = F.tid >> 2, q = F.tid & 3; const bf16_t* zp = Z + (size_t)(row0 + s) * DINP + ZC_ZV + g * 128 + q * 32;
      float x[32]; float ssq = 0.f;
#pragma unroll
      for (int c = 0; c < 4; ++c) { const u32x4 w = *(const u32x4*)(zp + c * 8);
          x[c * 8 + 0] = gelu_tanh_f(bflo(w.x)); x[c * 8 + 1] = gelu_tanh_f(bfhi(w.x)); x[c * 8 + 2] = gelu_tanh_f(bflo(w.y)); x[c * 8 + 3] = gelu_tanh_f(bfhi(w.y));
          x[c * 8 + 4] = gelu_tanh_f(bflo(w.z)); x[c * 8 + 5] = gelu_tanh_f(bfhi(w.z)); x[c * 8 + 6] = gelu_tanh_f(bflo(w.w)); x[c * 8 + 7] = gelu_tanh_f(bfhi(w.w)); }
#pragma unroll
      for (int i = 0; i < 32; ++i) ssq += x[i] * x[i];
      ssq += __shfl_xor(ssq, 1); ssq += __shfl_xor(ssq, 2);
      const float r = 1.0f / sqrtf(ssq * (1.0f / 128.0f) + EPS);
#pragma unroll
      for (int i = 0; i < 32; ++i) { const int d = q * 32 + i; Vt[d * SGU_LD + s] = (bf16_t)f2bf(x[i] * r * vgain[g * 128 + d]); } }
    const int tt = F.wave >> 1, r = F.lane & 31, h = F.lane >> 5;
    bf16_t zu[2][16]; float bb[16];
#pragma unroll
    for (int v = 0; v < 16; ++v) { const int t = 32 * tt + crow32(v, h); bb[v] = bs[g * 128 + t];
#pragma unroll
        for (int j = 0; j < 2; ++j) zu[j][v] = Z[(size_t)(row0 + t) * DINP + ZC_ZU + g * 128 + 32 * (2 * (F.wave & 1) + j) + r]; }
    lds_barrier();
    {
#pragma unroll
      for (int j = 0; j < 2; ++j) { const int td = 2 * (F.wave & 1) + j;
          f32x16 acc = {}; acc = mma32<8>(Wl + 32 * tt * SGU_LD, SGU_LD, Vt + 32 * td * SGU_LD, SGU_LD, acc, F.lane);
          const int d = 32 * td + r;
#pragma unroll
          for (int v = 0; v < 16; ++v) { const int t = 32 * tt + crow32(v, h);
              const float ov = gelu_tanh_f(bf2f(zu[j][v])) * (acc[v] + bb[v]);
#if OUT_FP8
              MIX[(size_t)(row0 + t) * DM + 1024 + g * 128 + d] = (unsigned char)(pk2_fp8(clamp8(ov), 0.f) & 0xFF); } } }
#else
              MIX[(size_t)(row0 + t) * DM + 1024 + g * 128 + d] = (bf16_t)f2bf(ov); } } }
#endif
}

__device__ __forceinline__ int gla_row0(int b, int c) { return c < 4 ? NLAT + b * CTXL + 64 * c : b * SEQ + 64 * (c - 4); }
__device__ __forceinline__ size_t gla_sidx(int b, int c, int h, int dir) { return ((((size_t)b * NCHUNK + c) * GH + h) * 2 + dir); }
constexpr int GLD = 72;
constexpr int BCS = 65, BCD = 64 * BCS;
constexpr int GO_A = 0;
constexpr int GO_B = GO_A + 18432 + 512;
constexpr int GO_Q = GO_B + 34816;
constexpr int GO_KT = GO_Q + 4 * 9216;
constexpr int GO_VT = GO_KT + 2 * 9216;
constexpr int GO_END = GO_VT + 18432;
static_assert(GO_END <= RING_BYTES + SCR_BYTES && 2 * BCD * 4 <= 34816, "GLA LDS map");

struct GlaPre { u32x4 qw, kw, vw0, vw1; unsigned short gi[4]; float gwv[4], gbv; };
__device__ __forceinline__ void gla_local_load(const Frame& F, const int l, const int gu, GlaPre& P) {
    const int h = gu & 3, c = (gu >> 2) % NCHUNK, b = (gu >> 2) / NCHUNK; const int row0 = gla_row0(b, c);
    const bf16_t* Z = (const bf16_t*)(F.ws + WS_R + R_Z);
#pragma unroll
    for (int j = 0; j < 4; ++j) { const int i = F.tid + 512 * j; const int dir = i >> 10, tok = (i >> 4) & 63, r = i & 15; P.gi[j] = Z[(size_t)(row0 + tok) * DINP + (dir ? ZC_GGB : ZC_GGF) + r]; }
    const float* wgf = kparams()->in[I_WGF]; const float* wgb = kparams()->in[I_WGB]; const float* bgf = kparams()->in[I_BGF]; const float* bgb = kparams()->in[I_BGB];
#pragma unroll
    for (int j = 0; j < 4; ++j) { const int i = F.tid + 512 * j; const int dir = i >> 10, r = (i >> 6) & 15, d = i & 63; P.gwv[j] = (dir ? wgb : wgf)[(size_t)l * 16 * 256 + r * 256 + h * 64 + d]; }
    { const int t = F.tid & 127; const int dir = t >> 6, d = t & 63; P.gbv = (dir ? bgb : bgf)[l * 256 + h * 64 + d]; }
    const int ti = F.tid >> 3, d0 = (F.tid & 7) * 8, e0 = (F.tid & 7) * 16; const bf16_t* zr = Z + (size_t)(row0 + ti) * DINP;
    P.qw = *(const u32x4*)(zr + ZC_GQ + h * 64 + d0); P.kw = *(const u32x4*)(zr + ZC_GK + h * 64 + d0);
    P.vw0 = *(const u32x4*)(zr + ZC_GV + h * 128 + e0); P.vw1 = *(const u32x4*)(zr + ZC_GV + h * 128 + e0 + 8);
}
__device__ __forceinline__ void gla_local_unit(const Frame& F, const int l, const int gu, const GlaPre& P, const bool has_next, const int gu_next, GlaPre& N) {
    const int h = gu & 3, c = (gu >> 2) % NCHUNK, b = (gu >> 2) / NCHUNK; const int row0 = gla_row0(b, c); (void)row0;
#if GL_BF16
    bf16_t* GL = (bf16_t*)(F.ws + WS_R + R_GL);
#else
    float* GL = (float*)(F.ws + WS_R + R_GL);
#endif
    float* lamout = (float*)(F.ws + WS_GLAM) + (size_t)gu * 128;
    bf16_t* QKG = (bf16_t*)(F.ws + WS_R + R_GQK) + (size_t)gu * (4 * 64 * 64); bf16_t* VTG = (bf16_t*)(F.ws + WS_R + R_GVT) + (size_t)gu * (128 * 64);
    LAS float* gin = (LAS float*)(F.lds + GO_A);
    LAS float* gw = gin + 2048;
    LAS float* gb = gw + 2048;
    LAS float* bc = (LAS float*)(F.lds + GO_B);
    LAS bf16_t* Kft = (LAS bf16_t*)(F.lds + GO_KT); LAS bf16_t* Kbt = Kft + 64 * GLD; LAS bf16_t* Vt = (LAS bf16_t*)(F.lds + GO_VT);
#pragma unroll
    for (int j = 0; j < 4; ++j) { gin[F.tid + 512 * j] = bf2f(P.gi[j]); gw[F.tid + 512 * j] = P.gwv[j]; }
    if (F.tid < 128) gb[F.tid] = P.gbv;
    const int ti = F.tid >> 3, d0 = (F.tid & 7) * 8, e0 = (F.tid & 7) * 16;
    const u32x4 qw = P.qw, kw = P.kw, vw0 = P.vw0, vw1 = P.vw1;
    if (has_next) gla_local_load(F, l, gu_next, N);
    lds_barrier();
    for (int rp_ = 0; rp_ < GS2; ++rp_) { asm volatile("" ::: "memory");
#pragma unroll
    for (int dir = 0; dir < 2; ++dir) { const int d = F.tid & 63; float wreg[16];
#pragma unroll
        for (int r = 0; r < 16; ++r) wreg[r] = gw[(dir * 16 + r) * 64 + d];
        const float bias = gb[dir * 64 + d];
#pragma unroll
        for (int j = 0; j < 8; ++j) { const int tok = (F.tid >> 6) + 8 * j; const LAS f32x4* gp = (const LAS f32x4*)(gin + (dir * 64 + tok) * 16); float x = bias;
#pragma unroll
            for (int q = 0; q < 4; ++q) { const f32x4 gv = gp[q]; x += (gv[0] * wreg[4 * q] + gv[1] * wreg[4 * q + 1]) + (gv[2] * wreg[4 * q + 2] + gv[3] * wreg[4 * q + 3]); }
            bc[dir * BCD + tok * BCS + d] = (fminf(x, 0.f) - __logf(1.0f + __expf(-fabsf(x)))) * (1.0f / 16.0f); } } }
    lds_barrier();
    { const int dir = F.wave >> 2;
#pragma unroll 4
      for (int j = 0; j < 16; ++j) { const int d = (F.wave & 3) * 16 + j; float x = bc[dir * BCD + F.lane * BCS + d];
          if (dir == 0) {
#pragma unroll
              for (int k = 1; k < 64; k <<= 1) { const float t = __shfl_up(x, k); if (F.lane >= k) x += t; }
              if (F.lane == 63) lamout[d] = __expf(x);
          } else {
#pragma unroll
              for (int k = 1; k < 64; k <<= 1) { const float t = __shfl_down(x, k); if (F.lane + k < 64) x += t; }
              if (F.lane == 0) lamout[64 + d] = __expf(x);
          }
          bc[dir * BCD + F.lane * BCS + d] = x; } }
    lds_barrier();
    for (int rp_ = 0; rp_ < GS4; ++rp_)
    { asm volatile("" ::: "memory"); const float q[8] = {bflo(qw.x), bfhi(qw.x), bflo(qw.y), bfhi(qw.y), bflo(qw.z), bfhi(qw.z), bflo(qw.w), bfhi(qw.w)};
      const float k[8] = {bflo(kw.x), bfhi(kw.x), bflo(kw.y), bfhi(kw.y), bflo(kw.z), bfhi(kw.z), bflo(kw.w), bfhi(kw.w)};
      unsigned qf[8], kf[8], qb[8], kb[8];
#pragma unroll
      for (int j = 0; j < 8; ++j) { const int d = d0 + j; const float bf = bc[ti * BCS + d], bb = bc[BCD + ti * BCS + d];
          qf[j] = f2bf(q[j] * 0.125f * __expf(bf)); qb[j] = f2bf(q[j] * 0.125f * __expf(bb)); kf[j] = f2bf(k[j] * __expf(-bf)); kb[j] = f2bf(k[j] * __expf(-bb));
          Kft[d * GLD + ti] = (bf16_t)kf[j]; Kbt[d * GLD + ti] = (bf16_t)kb[j]; }
      u32x4* dst = (u32x4*)(QKG + ti * 64 + d0);
      dst[0] = (u32x4){qf[0] | (qf[1] << 16), qf[2] | (qf[3] << 16), qf[4] | (qf[5] << 16), qf[6] | (qf[7] << 16)};
      dst[512] = (u32x4){kf[0] | (kf[1] << 16), kf[2] | (kf[3] << 16), kf[4] | (kf[5] << 16), kf[6] | (kf[7] << 16)};
      dst[1024] = (u32x4){qb[0] | (qb[1] << 16), qb[2] | (qb[3] << 16), qb[4] | (qb[5] << 16), qb[6] | (qb[7] << 16)};
      dst[1536] = (u32x4){kb[0] | (kb[1] << 16), kb[2] | (kb[3] << 16), kb[4] | (kb[5] << 16), kb[6] | (kb[7] << 16)};
      const unsigned ww[8] = {vw0.x, vw0.y, vw0.z, vw0.w, vw1.x, vw1.y, vw1.z, vw1.w};
#pragma unroll
      for (int t = 0; t < 8; ++t) { Vt[(e0 + 2 * t) * GLD + ti] = (bf16_t)(ww[t] & 0xffffu); Vt[(e0 + 2 * t + 1) * GLD + ti] = (bf16_t)(ww[t] >> 16); } }
    lds_barrier();
    for (int rp_ = 0; rp_ < GS5; ++rp_) { asm volatile("" ::: "memory");
#pragma unroll
    for (int k = 0; k < 2; ++k) { const int id = F.tid + 512 * k, row = id >> 3, cc = id & 7; *(u32x4*)(VTG + row * 64 + cc * 8) = *(const LAS u32x4*)(Vt + row * GLD + cc * 8); }
    { const int te = F.wave >> 1, td = F.wave & 1, r = F.lane & 31, hh = F.lane >> 5;
#pragma unroll
      for (int dir = 0; dir < 2; ++dir) {
          f32x16 acc = {}; acc = mma32<4>(Vt + 32 * te * GLD, GLD, (dir ? Kbt : Kft) + 32 * td * GLD, GLD, acc, F.lane);
#if GL_BF16
          bf16_t* dst = GL + ((size_t)gu * 2 + dir) * (GDV * GDK);
#pragma unroll
          for (int v = 0; v < 16; ++v) dst[(32 * te + crow32(v, hh)) * 64 + 32 * td + r] = (bf16_t)f2bf_sw(acc[v]); } } }
#else
          float* dst = GL + ((size_t)gu * 2 + dir) * (GDV * GDK);
#pragma unroll
          for (int v = 0; v < 16; ++v) dst[(32 * te + crow32(v, hh)) * 64 + 32 * td + r] = acc[v]; } } }
#endif
}
__device__ __forceinline__ void phase_gla_scan(const Frame& F) {
#if GL_BF16
    const bf16_t* __restrict__ GL = (const bf16_t*)(F.ws + WS_R + R_GL);
#define GL_LD(p) bf2f(*(p))
#else
    const float* __restrict__ GL = (const float*)(F.ws + WS_R + R_GL);
#define GL_LD(p) NT_LD(p)
#endif
    const float* __restrict__ LAM = (const float*)(F.ws + WS_GLAM); bf16_t* __restrict__ GS = (bf16_t*)(F.ws + WS_R + R_GS);
    for (int gid = F.bid * 512 + F.tid; gid < NB * GH * 2 * 4096; gid += F.G * 512) {
        const int el = gid & 4095, dir = (gid >> 12) & 1, h = (gid >> 13) & 3, b = gid >> 15; const int d = el & 63;
        float S0 = 0.f, S1 = 0.f;
        for (int p0 = 0; p0 < NCHUNK; p0 += 17) {
            float l0[17], l1[17], lm[17];
#pragma unroll
            for (int j = 0; j < 17; ++j) { const int pstep = p0 + j; const int c = (dir == 0) ? pstep : (pstep < 4 ? 3 - pstep : 71 - pstep); const size_t si = gla_sidx(b, c, h, dir);
                l0[j] = GL_LD(GL + si * 8192 + el); l1[j] = GL_LD(GL + si * 8192 + 4096 + el); lm[j] = LAM[si * 64 + d]; }
#pragma unroll
            for (int j = 0; j < 17; ++j) { const int pstep = p0 + j; const int c = (dir == 0) ? pstep : (pstep < 4 ? 3 - pstep : 71 - pstep); const size_t si = gla_sidx(b, c, h, dir);
                GS[si * 8192 + el] = (bf16_t)f2bf(S0); GS[si * 8192 + 4096 + el] = (bf16_t)f2bf(S1);
                S0 = lm[j] * (S0 + l0[j]); S1 = lm[j] * (S1 + l1[j]); }
        }
    }
}
struct GloPre { u32x4 qk[4], vt[2], z0, z1; bf16x8 sfr[2][4]; };
__device__ __forceinline__ void gla_out_load(const Frame& F, const int gu, GloPre& P) {
    const int h = gu & 3, c = (gu >> 2) % NCHUNK, b = (gu >> 2) / NCHUNK; const int row0 = gla_row0(b, c);
    const bf16_t* Z = (const bf16_t*)(F.ws + WS_R + R_Z); const bf16_t* GS = (const bf16_t*)(F.ws + WS_R + R_GS);
    const bf16_t* QKG = (const bf16_t*)(F.ws + WS_R + R_GQK) + (size_t)gu * (4 * 64 * 64); const bf16_t* VTG = (const bf16_t*)(F.ws + WS_R + R_GVT) + (size_t)gu * (128 * 64);
    const int r = F.lane & 31, hh = F.lane >> 5, te = F.wave & 3;
#pragma unroll
    for (int k = 0; k < 4; ++k) { const int row = F.tid >> 3, cc = F.tid & 7; P.qk[k] = NT_LD((const u32x4*)(QKG + k * 4096 + row * 64 + cc * 8)); }
#pragma unroll
    for (int k = 0; k < 2; ++k) { const int id = F.tid + 512 * k, row = id >> 3, cc = id & 7; P.vt[k] = NT_LD((const u32x4*)(VTG + row * 64 + cc * 8)); }
#pragma unroll
    for (int dir = 0; dir < 2; ++dir) { const bf16_t* S = GS + ((size_t)gu * 2 + dir) * 8192 + (size_t)(32 * te + r) * 64 + 8 * hh;
#pragma unroll
        for (int ks = 0; ks < 4; ++ks) P.sfr[dir][ks] = NT_LD((const bf16x8*)(S + ks * 16)); }
    const bf16_t* zrp = Z + (size_t)(row0 + (F.tid >> 3)) * DINP + ZC_GR + h * 128 + (F.tid & 7) * 16; P.z0 = *(const u32x4*)zrp; P.z1 = *(const u32x4*)(zrp + 8);
}
__device__ __forceinline__ void gla_out_unit(const Frame& F, const int l, const int gu, const GloPre& P, const bool has_next, const int gu_next, GloPre& N) {
    const int h = gu & 3, c = (gu >> 2) % NCHUNK, b = (gu >> 2) / NCHUNK; const int row0 = gla_row0(b, c);
    MixT* MIX = (MixT*)(F.ws + WS_R + R_MIX);
    LAS bf16_t* Af = (LAS bf16_t*)(F.lds + GO_A); LAS bf16_t* Ab = Af + 64 * GLD;
    LAS float* Ol = (LAS float*)(F.lds + GO_B);
    LAS bf16_t* Qf = (LAS bf16_t*)(F.lds + GO_Q); LAS bf16_t* Kf = Qf + 64 * GLD; LAS bf16_t* Qb = Kf + 64 * GLD; LAS bf16_t* Kb = Qb + 64 * GLD;
    LAS bf16_t* Vt = (LAS bf16_t*)(F.lds + GO_VT);
    const float* ogain = kparams()->in[I_GLAON] + l * 128;
#pragma unroll
    for (int k = 0; k < 4; ++k) { const int row = F.tid >> 3, cc = F.tid & 7; *(LAS u32x4*)(Qf + k * 64 * GLD + row * GLD + cc * 8) = P.qk[k]; }
#pragma unroll
    for (int k = 0; k < 2; ++k) { const int id = F.tid + 512 * k, row = id >> 3, cc = id & 7; *(LAS u32x4*)(Vt + row * GLD + cc * 8) = P.vt[k]; }
    const int r = F.lane & 31, hh = F.lane >> 5;
    bf16x8 sfr[2][4];
#pragma unroll
    for (int dir = 0; dir < 2; ++dir)
#pragma unroll
        for (int ks = 0; ks < 4; ++ks) sfr[dir][ks] = P.sfr[dir][ks];
    const u32x4 z0 = P.z0, z1 = P.z1;
    if (has_next) gla_out_load(F, gu_next, N);
    lds_barrier();
    { const int dir = F.wave >> 2, ti = (F.wave >> 1) & 1, tj = F.wave & 1;
      f32x16 acc = {}; acc = mma32<4>((dir ? Qb : Qf) + 32 * ti * GLD, GLD, (dir ? Kb : Kf) + 32 * tj * GLD, GLD, acc, F.lane);
      LAS bf16_t* A = dir ? Ab : Af; const int j = 32 * tj + r;
#pragma unroll
      for (int v = 0; v < 16; ++v) { const int i = 32 * ti + crow32(v, hh); const bool keep = dir ? (j >= i) : (j <= i);
          A[i * GLD + j] = (bf16_t)f2bf(keep ? acc[v] : 0.f); } }
    lds_barrier();
    { const int ti = F.wave >> 2, te = F.wave & 3;
      f32x16 acc = {};
      acc = mma32<4>(Af + 32 * ti * GLD, GLD, Vt + 32 * te * GLD, GLD, acc, F.lane);
      acc = mma32<4>(Ab + 32 * ti * GLD, GLD, Vt + 32 * te * GLD, GLD, acc, F.lane);
#pragma unroll
      for (int dir = 0; dir < 2; ++dir) { const LAS bf16_t* Qx = (dir ? Qb : Qf) + (32 * ti + r) * GLD + 8 * hh;
#pragma unroll
          for (int ks = 0; ks < 4; ++ks) { const bf16x8 a = *(const LAS bf16x8*)(Qx + ks * 16);
              acc = __builtin_amdgcn_mfma_f32_32x32x16_bf16(a, sfr[dir][ks], acc, 0, 0, 0); } }
#pragma unroll
      for (int v = 0; v < 16; ++v) Ol[(32 * ti + crow32(v, hh)) * 132 + 32 * te + r] = acc[v]; }
    lds_barrier();
    { const int i = F.tid >> 3, e0 = (F.tid & 7) * 16; float o[16]; float ssq = 0.f;
#pragma unroll
      for (int t = 0; t < 16; ++t) { o[t] = Ol[i * 132 + e0 + t]; ssq += o[t] * o[t]; }
      ssq += __shfl_xor(ssq, 1); ssq += __shfl_xor(ssq, 2); ssq += __shfl_xor(ssq, 4);
      const float rn = 1.0f / sqrtf(ssq * (1.0f / 128.0f) + EPS);
      MixT* mp = MIX + (size_t)(row0 + i) * DM + 1536 + h * 128 + e0;
      const unsigned zz[8] = {z0.x, z0.y, z0.z, z0.w, z1.x, z1.y, z1.z, z1.w};
#if OUT_FP8
      float a[16];
#pragma unroll
      for (int t = 0; t < 8; ++t) { a[2 * t] = clamp8(o[2 * t] * rn * ogain[e0 + 2 * t] * silu_f(bflo(zz[t]))); a[2 * t + 1] = clamp8(o[2 * t + 1] * rn * ogain[e0 + 2 * t + 1] * silu_f(bfhi(zz[t]))); }
      *(u32x4*)mp = (u32x4){pk4_fp8(a[0], a[1], a[2], a[3]), pk4_fp8(a[4], a[5], a[6], a[7]), pk4_fp8(a[8], a[9], a[10], a[11]), pk4_fp8(a[12], a[13], a[14], a[15])}; }
#else
      unsigned w[8];
#pragma unroll
      for (int t = 0; t < 8; ++t) { const float a0 = o[2 * t] * rn * ogain[e0 + 2 * t] * silu_f(bflo(zz[t])), a1 = o[2 * t + 1] * rn * ogain[e0 + 2 * t + 1] * silu_f(bfhi(zz[t])); w[t] = cvt_pk_bf16(a0, a1); }
      *(u32x4*)mp = (u32x4){w[0], w[1], w[2], w[3]}; *(u32x4*)(mp + 8) = (u32x4){w[4], w[5], w[6], w[7]}; }
#endif
}

__device__ __forceinline__ void phase_router(const Frame& F, const int l, const int nrows) {
    LAS float* Wg = (LAS float*)F.lds;
    LAS bf16_t* We = (LAS bf16_t*)(F.lds + 4 * 2048 * 4);
    LAS int* lcnt = (LAS int*)F.scr;
    LAS int* lbase = lcnt + 16;
    LAS int* rec = lcnt + 32;
    const float* wgs = kparams()->in[I_MWG] + (size_t)l * 2048 * 4; const float* wes = kparams()->in[I_MWE] + (size_t)l * 2048 * 16;
    for (int k = F.tid; k < 2048; k += 512) { const f32x4 g = *(const f32x4*)(wgs + k * 4);
#pragma unroll
        for (int o = 0; o < 4; ++o) Wg[o * 2048 + k] = g[o];
#pragma unroll
        for (int q = 0; q < 4; ++q) { const f32x4 e = *(const f32x4*)(wes + k * 16 + 4 * q);
#pragma unroll
            for (int o = 0; o < 4; ++o) We[(4 * q + o) * 2048 + k] = (bf16_t)f2bf(e[o]); } }
    if (F.tid < 16) lcnt[F.tid] = 0;
    __syncthreads();
    const int RPB = nrows / F.G;
    const bf16_t* X1 = (const bf16_t*)(F.ws + WS_X1); unsigned* H8 = (unsigned*)(F.ws + WS_H);
    const float* modl = (const float*)(F.ws + WS_MOD) + (size_t)l * 5 * 12288; const float* n2g = kparams()->in[I_N2G] + l * 2048;
    const float* bg = kparams()->in[I_MBG] + l * 4; const float* be = kparams()->in[I_MBE] + l * 16;
    float* cw = (float*)(F.ws + WS_CW);
    typedef __bf16 bf16x2_t __attribute__((ext_vector_type(2)));
    LAS float* lgs = (LAS float*)(F.lds + 4 * 2048 * 4 + 16 * 2048 * 2) + F.wave * 64;
    for (int rrep = 0; rrep < RP_RT; ++rrep)
    for (int it = 0; it * 16 + 2 * F.wave < RPB; ++it) {
        const int rl0 = it * 16 + 2 * F.wave;
        f32x4 v[2][8]; unsigned hb[2][16]; float rr[2];
#pragma unroll
        for (int q = 0; q < 2; ++q) { const bf16_t* src = X1 + (size_t)(F.bid * RPB + rl0 + q) * DM; float s = 0.f;
#pragma unroll
            for (int i = 0; i < 8; ++i) { const u32x2 xw = *(const u32x2*)(src + 256 * i + 4 * F.lane); v[q][i] = (f32x4){bflo(xw.x), bfhi(xw.x), bflo(xw.y), bfhi(xw.y)}; s += (v[q][i][0] * v[q][i][0] + v[q][i][1] * v[q][i][1]) + (v[q][i][2] * v[q][i][2] + v[q][i][3] * v[q][i][3]); }
            rr[q] = s; }
#pragma unroll
        for (int q = 0; q < 2; ++q) { const int row = F.bid * RPB + rl0 + q; const int mr = mod_row_of(row);
            const float* msh = modl + (size_t)mr * 12288 + 3 * DM; const float* msc = modl + (size_t)mr * 12288 + 4 * DM;
            const float r = 1.0f / sqrtf(wave_sum(rr[q]) * (1.0f / DM) + EPS);
            unsigned* hp = H8 + (size_t)row * (MOE_FP8 ? DM / 4 : DM / 2);
#pragma unroll
            for (int i = 0; i < 8; ++i) { const int k = 256 * i + 4 * F.lane; const f32x4 g = *(const f32x4*)(n2g + k), sc = *(const f32x4*)(msc + k), sh = *(const f32x4*)(msh + k);
                v[q][i] = v[q][i] * r * g * (sc + 1.0f) + sh;
                hb[q][2 * i] = cvt_pk_bf16(v[q][i][0], v[q][i][1]); hb[q][2 * i + 1] = cvt_pk_bf16(v[q][i][2], v[q][i][3]);
#if MOE_FP8
                hp[64 * i + F.lane] = pk4_fp8(v[q][i][0], v[q][i][1], v[q][i][2], v[q][i][3]); }
#else
                *(u32x2*)((bf16_t*)hp + k) = (u32x2){hb[q][2 * i], hb[q][2 * i + 1]}; }
#endif
        }
        float p[2][32];
#pragma unroll
        for (int q = 0; q < 2; ++q)
#pragma unroll
            for (int o = 20; o < 32; ++o) p[q][o] = 0.f;
#pragma unroll
        for (int o = 0; o < 4; ++o) { float a0 = 0.f, a1 = 0.f;
#pragma unroll
            for (int i = 0; i < 8; ++i) { const f32x4 w = *(const LAS f32x4*)(Wg + o * 2048 + 256 * i + 4 * F.lane);
                a0 += (v[0][i][0] * w[0] + v[0][i][1] * w[1]) + (v[0][i][2] * w[2] + v[0][i][3] * w[3]); a1 += (v[1][i][0] * w[0] + v[1][i][1] * w[1]) + (v[1][i][2] * w[2] + v[1][i][3] * w[3]); }
            p[0][o] = a0; p[1][o] = a1; }
#pragma unroll
        for (int o = 0; o < 16; ++o) { float a0 = 0.f, a1 = 0.f;
#pragma unroll
            for (int i = 0; i < 8; ++i) { const u32x2 w = *(const LAS u32x2*)(We + o * 2048 + 256 * i + 4 * F.lane);
                const bf16x2_t wx = __builtin_bit_cast(bf16x2_t, w.x), wy = __builtin_bit_cast(bf16x2_t, w.y);
#ifndef RT_DOT2
                a0 += (bflo(hb[0][2 * i]) * bflo(w.x) + bfhi(hb[0][2 * i]) * bfhi(w.x)) + (bflo(hb[0][2 * i + 1]) * bflo(w.y) + bfhi(hb[0][2 * i + 1]) * bfhi(w.y));
                a1 += (bflo(hb[1][2 * i]) * bflo(w.x) + bfhi(hb[1][2 * i]) * bfhi(w.x)) + (bflo(hb[1][2 * i + 1]) * bflo(w.y) + bfhi(hb[1][2 * i + 1]) * bfhi(w.y)); (void)wx; (void)wy; }
#else
                a0 = __builtin_amdgcn_fdot2_f32_bf16(__builtin_bit_cast(bf16x2_t, hb[0][2 * i]), wx, a0, false); a0 = __builtin_amdgcn_fdot2_f32_bf16(__builtin_bit_cast(bf16x2_t, hb[0][2 * i + 1]), wy, a0, false);
                a1 = __builtin_amdgcn_fdot2_f32_bf16(__builtin_bit_cast(bf16x2_t, hb[1][2 * i]), wx, a1, false); a1 = __builtin_amdgcn_fdot2_f32_bf16(__builtin_bit_cast(bf16x2_t, hb[1][2 * i + 1]), wy, a1, false); }
#endif
            p[0][4 + o] = a0; p[1][4 + o] = a1; }
#define FOLD(N, OFF) do { const bool up = (F.lane & (OFF)) != 0; _Pragma("unroll") for (int q = 0; q < 2; ++q) _Pragma("unroll") for (int j = 0; j < (N) / 2; ++j) { \
            const float snd = up ? p[q][j] : p[q][j + (N) / 2], kp = up ? p[q][j + (N) / 2] : p[q][j]; p[q][j] = kp + __shfl_xor(snd, (OFF)); } } while (0)
        FOLD(32, 32); FOLD(16, 16); FOLD(8, 8); FOLD(4, 4); FOLD(2, 2);
#undef FOLD
        const int idx = ((F.lane >> 5) & 1) * 16 + ((F.lane >> 4) & 1) * 8 + ((F.lane >> 3) & 1) * 4 + ((F.lane >> 2) & 1) * 2 + ((F.lane >> 1) & 1);
#pragma unroll
        for (int q = 0; q < 2; ++q) { const float tot = p[q][0] + __shfl_xor(p[q][0], 1); if ((F.lane & 1) == 0) lgs[q * 32 + idx] = tot; }
        LDS_WAIT(); asm volatile("" ::: "memory");
#pragma unroll
        for (int q = 0; q < 2; ++q) { const int row = F.bid * RPB + rl0 + q;
            float lg[4], le[16];
#pragma unroll
            for (int o = 0; o < 4; ++o) lg[o] = lgs[q * 32 + o] + bg[o];
#pragma unroll
            for (int o = 0; o < 16; ++o) le[o] = lgs[q * 32 + 4 + o] + be[o];
            int gsel = 0; float gm = lg[0];
#pragma unroll
            for (int o = 1; o < 4; ++o) if (lg[o] > gm) { gm = lg[o]; gsel = o; }
            float gden = 0.f;
#pragma unroll
            for (int o = 0; o < 4; ++o) gden += __expf(lg[o] - gm);
            const float gwt = 1.0f / gden;
            float el[4];
#pragma unroll
            for (int j = 0; j < 4; ++j) el[j] = gsel == 0 ? le[j] : gsel == 1 ? le[4 + j] : gsel == 2 ? le[8 + j] : le[12 + j];
            int i0 = 0; float m0 = el[0];
#pragma unroll
            for (int j = 1; j < 4; ++j) if (el[j] > m0) { m0 = el[j]; i0 = j; }
            int i1 = -1; float m1 = -3.0e38f;
#pragma unroll
            for (int j = 0; j < 4; ++j) if (j != i0 && el[j] > m1) { m1 = el[j]; i1 = j; }
            const float ex = __expf(m1 - m0); const float w0 = 1.0f / (1.0f + ex), w1 = ex / (1.0f + ex);
            if (F.lane == 0 && rrep == RP_RT - 1) { const int e0 = 4 * gsel + i0, e1 = 4 * gsel + i1; const int rl = rl0 + q;
                const int x0 = atomicAdd((int*)(lcnt + e0), 1), x1 = atomicAdd((int*)(lcnt + e1), 1);
                rec[rl * 4 + 0] = e0; rec[rl * 4 + 1] = e1; rec[rl * 4 + 2] = x0; rec[rl * 4 + 3] = x1;
                cw[row * 2] = gwt * w0; cw[row * 2 + 1] = gwt * w1; } }
        LDS_WAIT(); asm volatile("" ::: "memory");
    }
    __syncthreads();
    unsigned* gcnt = F.ctl + CW_CNT + l * 64;
    if (F.tid < 16) lbase[F.tid] = (int)__hip_atomic_fetch_add(gcnt + F.tid, (unsigned)lcnt[F.tid], __ATOMIC_RELAXED, __HIP_MEMORY_SCOPE_AGENT);
    __syncthreads();
    if (F.tid < RPB) { const int row = F.bid * RPB + F.tid; int* te = (int*)(F.ws + WS_TOKE); int* ti = (int*)(F.ws + WS_TOKI);
        const int e0 = rec[F.tid * 4], e1 = rec[F.tid * 4 + 1];
        const int x0 = lbase[e0] + rec[F.tid * 4 + 2], x1 = lbase[e1] + rec[F.tid * 4 + 3];
        te[row * 2] = e0; te[row * 2 + 1] = e1; ti[row * 2] = x0; ti[row * 2 + 1] = x1;
#if MOE_GATHER
        unsigned short* list = (unsigned short*)(F.ws + WS_LIST); list[(size_t)e0 * NTOK + x0] = (unsigned short)row; list[(size_t)e1 * NTOK + x1] = (unsigned short)row;
#endif
    }
    __syncthreads();
}
__device__ __forceinline__ void phase_permute(const Frame& F, const int l, const int nrows) {
    LAS int* tstart = (LAS int*)(F.scr + 8192);
    moe_table(F, l, tstart);
    const unsigned char* H = F.ws + WS_H; unsigned char* H2S = F.ws + WS_R + R_H2S;
    const int* te = (const int*)(F.ws + WS_TOKE); const int* ti = (const int*)(F.ws + WS_TOKI); int* ts = (int*)(F.ws + WS_TOKS);
    const int gw = F.bid * 8 + F.wave, NGW = F.G * 8;
    for (int row = gw; row < nrows; row += NGW) {
        const int s0 = tstart[te[row * 2]] * 256 + ti[row * 2], s1 = tstart[te[row * 2 + 1]] * 256 + ti[row * 2 + 1];
        if (F.lane == 0) { ts[row * 2] = s0; ts[row * 2 + 1] = s1; }
        constexpr int RB = MOE_FP8 ? DM : DM * 2;
        const u32x4* src = (const u32x4*)(H + (size_t)row * RB) + F.lane; u32x4* d0 = (u32x4*)(H2S + (size_t)s0 * RB) + F.lane; u32x4* d1 = (u32x4*)(H2S + (size_t)s1 * RB) + F.lane;
#pragma unroll
        for (int i = 0; i < RB / 1024; ++i) { const u32x4 x = NT_LD(src + 64 * i); d0[64 * i] = x; d1[64 * i] = x; }
    }
}

#define REPEAT(n) for (int rep_ = 0; rep_ < (n); ++rep_)
constexpr int NPH = 11, NPHASES = DEPTH * NPH + 1;
#if MK_ONE_LAUNCH
#define GRID_BAR() do { for (int rb_ = 0; rb_ < RP_BAR; ++rb_) xcd_barrier(bar); } while (0)
#else
#define GRID_BAR() do {} while (0)
#endif
#ifdef ONLY_PHASE
#define IN(k) ((((k) % NPH) == ONLY_PHASE || ((k) == DEPTH * NPH && ONLY_PHASE == NPH)) && lo <= (k) && (k) < hi)
#else
#define IN(k) (lo <= (k) && (k) < hi)
#endif
#define SEAM(k) do { if (IN(k) && IN((k) + 1)) GRID_BAR(); } while (0)
#define PHASE_FRAME() Frame F; { F.lds = (LAS unsigned char*)lds_raw; F.scr = F.lds + SCR_OFF; F.MISC = (volatile LAS unsigned*)(F.lds + MISC_OFF); \
        int tz = wave_s * 64 + lane_id(); asm volatile("" : "+v"(tz)); F.tid = tz; F.lane = tz & 63; F.wave = __builtin_amdgcn_readfirstlane(tz >> 6); \
        int bz = blockIdx.x; asm volatile("" : "+s"(bz)); F.G = gridDim.x; F.bid = bz; \
        F.ws = kparams()->ws; F.ctl = (unsigned*)(F.ws + WS_CTL); } \
        unsigned char* const wb = F.ws + WS_W + (size_t)PF_LAYER * WL_BYTES; unsigned char* const R = F.ws + WS_R; (void)wb; (void)R

#ifndef W_PRE16
#define W_PRE16 0
#endif
template <int l>
__device__ __forceinline__ void layer_body(unsigned char* lds_raw, const int wave_s, const int lo, const int hi, const XcdBarrier& bar) {
    constexpr int P0 = l * NPH; constexpr bool ctx_out = (l < DEPTH - 1); constexpr int PF_LAYER = l;
    constexpr int WPRE = (l >= 1) ? W_PRE16 : 0;
    constexpr int nrows = ctx_out ? NTOK : NLAT, nMt = nrows / 256;
    if (IN(P0 + 0)) REPEAT(RP_W) { PHASE_FRAME(); phase_weights(F, l, WPRE, 16, F.G, F.bid, true, (W_FILL != 0 && l >= 1) ? (int)F.MISC[32 + F.wave] : 0); if (RP_W > 1) __syncthreads(); } SEAM(P0 + 0);
    if (IN(P0 + 1)) REPEAT(RP_ROWS) { PHASE_FRAME(); phase_rows<(l == 0) ? 0 : 1>(F, l); if (RP_ROWS > 1) __syncthreads(); } SEAM(P0 + 1);
    if (IN(P0 + 2)) { PHASE_FRAME(); TileSched S; S.init(F.ws + WS_H, DM, wb + W_IN, DM, NTOK / 256, DINP / 256, F.G, F.bid, RP_GIN);
        EpiZ E{(bf16_t*)(R + R_Z), (float*)(F.ws + WS_RSQ)};
        pg8::gemm_phase<EpiZ, TileSched, false, ALIGN_PLAIN>(F.tid, F.lds, F.scr, DM * 2, DM * 2, S, E); } SEAM(P0 + 2);
    if (IN(P0 + 3)) { PHASE_FRAME(); UpSched S; S.rep = RP_UP; S.Z = (const char*)(R + R_Z); S.Wq = (const char*)(wb + W_UQ); S.Wkv = (const char*)(wb + W_UKV); S.nQ = nMt * 8; S.ntot = S.nQ + (NTOK / 256) * 8; S.G = F.G; S.c = F.bid;
        EpiUp E{(const bf16_t*)(R + R_Z), (const float*)(F.ws + WS_RSQ), kparams()->in[I_QGAIN] + l * QKD, kparams()->in[I_KGAIN] + l * QKD, (const f32x2*)(F.ws + WS_ROPE), (bf16_t*)(R + R_Q), (bf16_t*)(R + R_K), (bf16_t*)(R + R_V)};
        pg8::gemm_phase<EpiUp, UpSched>(F.tid, F.lds, F.scr, DINP * 2, 512 * 2, S, E); }
    if (IN(P0 + 3)) { PHASE_FRAME();
        unsigned* qh = F.ctl + CW_Q + 64 * (4 * l + 0); constexpr int nS = (ctx_out ? 136 : 128) * 4;
        constexpr bool FILL = ((W_FILL & 1) != 0) && (l + 1 < DEPTH); int wdone = FILL ? (int)F.MISC[32 + F.wave] : 0; LAS unsigned* wscr = (LAS unsigned*)(F.lds + 2 * 128 * SGU_LD * 2 + F.wave * 4608);
        UnitQ q; q_first(F, qh, q); for (;;) { int u, un; q_next(F, qh, q, u, un); if (u >= nS * RP_SGU) break;
            if constexpr (FILL) { const int kq = F.lane >> 3, n4 = F.lane & 7; LAS unsigned* scr = wscr; WF_DECL(); WF_LOAD(l + 1, wdone); sgu_unit(F, l, u % nS); WF_STORE(wdone); } else sgu_unit(F, l, u % nS); }
        if (FILL && F.lane == 0) F.MISC[32 + F.wave] = (unsigned)wdone; }
    if (IN(P0 + 3)) { PHASE_FRAME();
        unsigned* qh = F.ctl + CW_Q + 64 * (4 * l + 3); constexpr int nG = NB * NCHUNK * GH;
        constexpr bool FILL = ((W_FILL & 2) != 0) && (l + 1 < DEPTH); int wdone = FILL ? (int)F.MISC[32 + F.wave] : 0; LAS unsigned* wscr = (LAS unsigned*)(F.lds + GO_Q + F.wave * 4608);
        UnitQ q; q_first(F, qh, q); GlaPre PA, PB; bool first = true;
        for (;;) { int u, un; q_next(F, qh, q, u, un); if (u >= nG * RP_GLAL) break;
            if (first) { gla_local_load(F, l, u % nG, PA); first = false; }
            if constexpr (FILL) { const int kq = F.lane >> 3, n4 = F.lane & 7; LAS unsigned* scr = wscr; WF_DECL(); WF_LOAD(l + 1, wdone); gla_local_unit(F, l, u % nG, PA, un < nG * RP_GLAL, un % nG, PB); WF_STORE(wdone); }
            else gla_local_unit(F, l, u % nG, PA, un < nG * RP_GLAL, un % nG, PB);
            PA = PB; }
        if (FILL && F.lane == 0) F.MISC[32 + F.wave] = (unsigned)wdone; } SEAM(P0 + 3);
    if (IN(P0 + 4)) { PHASE_FRAME(); REPEAT(RP_SCAN) phase_gla_scan(F);
        VM_WAIT(); __syncthreads();
        if (F.tid == 0) { __builtin_amdgcn_fence(__ATOMIC_RELEASE, "agent"); asm volatile("s_waitcnt vmcnt(0)" ::: "memory");
            __hip_atomic_fetch_add(F.ctl + CW_Q + 64 * (4 * l + 1), 1u, __ATOMIC_RELAXED, __HIP_MEMORY_SCOPE_AGENT); } }
    if (IN(P0 + 4)) { PHASE_FRAME();
        const bf16_t* Qb = (const bf16_t*)(R + R_Q); const bf16_t* Kb = (const bf16_t*)(R + R_K); const bf16_t* Vb = (const bf16_t*)(R + R_V); MixT* MIX = (MixT*)(R + R_MIX);
        constexpr int nlat = NB * NH * (SEQ / 256), nun = nlat + (ctx_out ? NB * NH : 0);
        for (int un_ = F.bid; un_ < nun * RP_ATTN; un_ += F.G) { const int un = un_ % nun;
            int qrow, h, rowA, rowB, NT;
            if (un < nlat) {
                int pr, qb; if ((F.G & 7) == 0 && F.G == 256) { const int xcd = un & 7, idx = (un >> 3) & 31, rnd = un >> 8; pr = 4 * xcd + 2 * rnd + (idx >> 4); qb = idx & 15; } else { pr = un >> 4; qb = un & 15; }
                const int b = pr >> 3; h = pr & 7; qrow = b * SEQ + qb * 256; rowA = NLAT + b * CTXL; rowB = b * SEQ; NT = (CTXL + SEQ) / 64; }
            else { const int u2 = un - nlat, b = u2 >> 3; h = u2 & 7; qrow = NLAT + b * CTXL; rowA = qrow; rowB = 0; NT = CTXL / 64; }
            attn::attn_body(F.tid, Qb + (size_t)qrow * QLD + h * QKD, Kb + h * QKD, Vb + h * VD, MIX + (size_t)qrow * DM + h * VD, rowA, CTXL / 64, rowB, NT, (char*)lds_raw);
        } }
    if (IN(P0 + 4)) { PHASE_FRAME();
        if (F.tid == 0) { unsigned* flag = F.ctl + CW_Q + 64 * (4 * l + 1); unsigned sp = 0;
            while (__hip_atomic_load(flag, __ATOMIC_RELAXED, __HIP_MEMORY_SCOPE_AGENT) < (unsigned)F.G) { __builtin_amdgcn_s_sleep(2); if (++sp > (1u << 22)) break; }
            __builtin_amdgcn_fence(__ATOMIC_ACQUIRE, "agent"); asm volatile("s_waitcnt vmcnt(0)" ::: "memory"); }
        __syncthreads();
        unsigned* qh = F.ctl + CW_Q + 64 * (4 * l + 2); constexpr int nO = NB * (ctx_out ? NCHUNK : NCHUNK - 4) * GH;
        UnitQ q; q_first(F, qh, q); GloPre PA, PB; bool first = true;
        auto gmap = [&](int u) { int gu = u; if (!ctx_out) { const int hq = u & 3, cc = 4 + ((u >> 2) & 63), bb = u >> 8; gu = ((bb * NCHUNK + cc) * GH) + hq; } return gu; };
        for (;;) { int u_, un_; q_next(F, qh, q, u_, un_); if (u_ >= nO * RP_GLAO) break;
            const int gu = gmap(u_ % nO), gun = gmap(un_ % nO);
            if (first) { gla_out_load(F, gu, PA); first = false; }
            gla_out_unit(F, l, gu, PA, un_ < nO * RP_GLAO, gun, PB); PA = PB; } } SEAM(P0 + 4);
    if (IN(P0 + 6)) { PHASE_FRAME(); const float* modl = (const float*)(F.ws + WS_MOD) + (size_t)l * 5 * 12288; constexpr int OEB = OUT_FP8 ? 1 : 2; TileSched S; S.init(R + R_MIX, DM * OEB / 2, wb + W_OUT, DM * OEB / 2, nMt, DM / 256, F.G, F.bid, RP_OUT);
        if constexpr (l == 0) { EpiResid<false> E{kparams()->in[I_X], kparams()->in[I_CTX], modl, (bf16_t*)(F.ws + WS_X1)};
            pg8::gemm_phase<EpiResid<false>, TileSched, OUT_FP8 != 0, ALIGN_F8, F8_SP2>(F.tid, F.lds, F.scr, DM * OEB, DM * OEB, S, E); }
        else { EpiResid<true> E{F.ws + WS_X2, F.ws + WS_X2 + (size_t)NLAT * DM * 2, modl, (bf16_t*)(F.ws + WS_X1)};
            pg8::gemm_phase<EpiResid<true>, TileSched, OUT_FP8 != 0, ALIGN_F8, F8_SP2>(F.tid, F.lds, F.scr, DM * OEB, DM * OEB, S, E); } }
    if (IN(P0 + 6) && l + 1 < DEPTH && W_PRE16 > 0) { PHASE_FRAME(); constexpr int nbusy = (nMt * (DM / 256)) % 256;
        if (F.G == 256 && F.bid >= nbusy) phase_weights(F, l + 1, 0, W_PRE16, F.G - nbusy, F.bid - nbusy, false); } SEAM(P0 + 6);
    if (IN(P0 + 7)) { PHASE_FRAME(); phase_router(F, l, nrows); } SEAM(P0 + 7);
#if !MOE_GATHER
    if (IN(P0 + 8)) REPEAT(RP_PERM) { PHASE_FRAME(); phase_permute(F, l, nrows); if (RP_PERM > 1) __syncthreads(); } SEAM(P0 + 8);
#endif
    if (IN(P0 + 9)) { PHASE_FRAME(); LAS int* tstart = (LAS int*)(F.scr + 8192); moe_table(F, l, tstart);
        constexpr int EB = MOE_FP8 ? 1 : 2;
#if MOE_GATHER
        MoeSchedG S; S.A = (const char*)(F.ws + WS_H);
#else
        MoeSched S; S.A = (const char*)(R + R_H2S);
#endif
        S.W = (const char*)(wb + W_GU); S.a_tile = 256 * (size_t)DM * EB; S.w_exp = (size_t)2048 * 2048 * EB; S.b_tile = 256 * (size_t)2048 * EB;
        S.tstart = tstart; S.ntot = tstart[16] * 8; S.G = F.G; S.c = F.bid; S.rep = RP_M1;
#if MOE_GATHER
        { LAS unsigned* gtab = (LAS unsigned*)F.scr; S.gtab = gtab; const unsigned short* list = (const unsigned short*)(F.ws + WS_LIST);
          for (int i = 0; i < 8; ++i) { pg8::Unit u; if (!S.next(i, u)) break;
              if (F.tid < 256) { const int e = u.aux, idx = (u.pm - tstart[e]) * 256 + F.tid; const unsigned tok = idx < tstart[32 + e] ? (unsigned)list[(size_t)e * NTOK + idx] : 0u; gtab[i * 256 + F.tid] = tok * (unsigned)(DM * EB); } }
          __syncthreads(); }
#endif
        EpiSwiglu E{R + R_ACT};
        pg8::gemm_phase<EpiSwiglu, decltype(S), MOE_FP8 != 0, ALIGN_F8, F8_SP2>(F.tid, F.lds, F.scr, DM * EB, DM * EB, S, E); } SEAM(P0 + 9);
    if (IN(P0 + 10)) { PHASE_FRAME(); LAS int* tstart = (LAS int*)(F.scr + 8192); moe_table(F, l, tstart);
        MoeSched S; S.A = (const char*)(R + R_ACT); S.W = (const char*)(wb + W_2); constexpr int EB = MOE_FP8 ? 1 : 2; S.a_tile = 256 * (size_t)DEXP * EB; S.w_exp = (size_t)2048 * 1024 * EB; S.b_tile = 256 * (size_t)1024 * EB;
        S.tstart = tstart; S.ntot = tstart[16] * 8; S.G = F.G; S.c = F.bid; S.rep = RP_M2;
        EpiBf16 E{(bf16_t*)(R + R_Y), DM};
        pg8::gemm_phase<EpiBf16, MoeSched, MOE_FP8 != 0, ALIGN_F8, F8_SP2>(F.tid, F.lds, F.scr, DEXP * EB, DEXP * EB, S, E); }
    if constexpr (l + 1 < DEPTH && MK_ONE_LAUNCH) {   } else SEAM(P0 + 10);
}

__global__ void __launch_bounds__(512, 2) hybrid_fwd(Params p) {
    extern __shared__ __attribute__((aligned(16))) unsigned char lds_raw[];
    const int wave_s = __builtin_amdgcn_readfirstlane((int)threadIdx.x >> 6);
    { LAS unsigned* m = (LAS unsigned*)((LAS unsigned char*)lds_raw + MISC_OFF); if (wave_s == 0) m[lane_id()] = 0u; }
    __syncthreads();
#if MK_ONE_LAUNCH
    const XcdBarrier bar = xcd_barrier_post((unsigned*)(kparams()->ws + WS_CTL) + CW_BAR, (volatile LAS unsigned*)((LAS unsigned char*)lds_raw + MISC_OFF) + 8);
#else
    XcdBarrier bar; bar.bar = nullptr; bar.x = 0; bar.st = nullptr;
#endif
    const int lo = kparams()->ph_lo, hi = kparams()->ph_hi;
    layer_body<0>(lds_raw, wave_s, lo, hi, bar);
    layer_body<1>(lds_raw, wave_s, lo, hi, bar);
    if (IN(DEPTH * NPH)) { constexpr int PF_LAYER = DEPTH - 1; PHASE_FRAME(); phase_rows<2>(F, DEPTH - 1); }
}
#undef IN
#undef SEAM
#undef GRID_BAR
static_assert(DEPTH == 2, "two layer_body instantiations");

extern "C" void kernel_launch(void* const* d_in, const int* in_sizes, int n_in, void* d_out, int out_size, void* d_ws, size_t ws_size, hipStream_t stream) {
    static int grid = 0;
    if (grid == 0) {
        if (n_in != 31 || out_size != NLAT * DM || ws_size < WS_END) { fprintf(stderr, "kernel_launch: unexpected shapes (n_in %d, out %d, ws %zu, need %zu)\n", n_in, out_size, ws_size, (size_t)WS_END); grid = -1; return; }
        int dev = 0, cus = 0, per_cu = 0;
        if (hipGetDevice(&dev) != hipSuccess || hipDeviceGetAttribute(&cus, hipDeviceAttributeMultiprocessorCount, dev) != hipSuccess) { grid = -1; return; }
        if (hipFuncSetAttribute((const void*)hybrid_fwd, hipFuncAttributeMaxDynamicSharedMemorySize, LDS_BYTES) != hipSuccess) { fprintf(stderr, "kernel_launch: hipFuncSetAttribute failed\n"); grid = -1; return; }
        if (hipOccupancyMaxActiveBlocksPerMultiprocessor(&per_cu, (const void*)hybrid_fwd, 512, LDS_BYTES) != hipSuccess || per_cu < 1) { fprintf(stderr, "kernel_launch: occupancy query reports %d\n", per_cu); }
        (void)hipGetLastError();
        grid = cus;
        if (grid > 256) grid = 256;
    }
    if (grid < 0) return;
    (void)hipMemsetAsync((char*)d_ws + WS_CTL, 0, CTL_ZERO_BYTES, stream);
    Params a{};
    for (int i = 0; i < 31; ++i) a.in[i] = (const float*)d_in[i];
    a.out = (float*)d_out; a.ws = (unsigned char*)d_ws;
#if MK_ONE_LAUNCH
    a.ph_lo = 0; a.ph_hi = NPHASES;
    hipLaunchKernelGGL(hybrid_fwd, dim3(grid), dim3(512), LDS_BYTES, stream, a);
#else
    for (int ph = 0; ph < NPHASES; ++ph) { a.ph_lo = ph; a.ph_hi = ph + 1; hipLaunchKernelGGL(hybrid_fwd, dim3(grid), dim3(512), LDS_BYTES, stream, a); }
#endif
}
```

```cpp
#include <hip/hip_runtime.h>
#include <stdint.h>
#include <stdio.h>

#ifndef MK_ONE_LAUNCH
#define MK_ONE_LAUNCH 1
#endif

#ifndef RP_W
#define RP_W 1
#endif
#ifndef RP_ROWS
#define RP_ROWS 1
#endif
#ifndef RP_GIN
#define RP_GIN 1
#endif
#ifndef RP_UP
#define RP_UP 1
#endif
#ifndef RP_SGU
#define RP_SGU 1
#endif
#ifndef RP_GLAL
#define RP_GLAL 1
#endif
#ifndef RP_SCAN
#define RP_SCAN 1
#endif
#ifndef RP_ATTN
#define RP_ATTN 1
#endif
#ifndef RP_GLAO
#define RP_GLAO 1
#endif
#ifndef RP_OUT
#define RP_OUT 1
#endif
#ifndef RP_PERM
#define RP_PERM 1
#endif
#ifndef RP_M1
#define RP_M1 1
#endif
#ifndef RP_M2
#define RP_M2 1
#endif
#ifndef GS1
#define GS1 1
#endif
#ifndef GS2
#define GS2 1
#endif
#ifndef GS4
#define GS4 1
#endif
#ifndef GS5
#define GS5 1
#endif
#ifndef ALIGN_PLAIN
#define ALIGN_PLAIN true
#endif
#ifndef W_NT
#define W_NT 1
#endif
#ifndef W_NTS
#define W_NTS 1
#endif
#ifndef MOE_BNT
#define MOE_BNT 0
#endif
#ifndef NT2
#define NT2 1
#endif
#if NT2
#define NT_LD(p) __builtin_nontemporal_load(p)
#define NT_ST(v, p) __builtin_nontemporal_store(v, p)
#else
#define NT_LD(p) (*(p))
#define NT_ST(v, p) (*(p) = (v))
#endif
#ifndef RP_EPI
#define RP_EPI 1
#endif
#ifndef RP_ADA
#define RP_ADA 1
#endif
#ifndef RP_TR
#define RP_TR 1
#endif
#ifndef RP_RT
#define RP_RT 1
#endif
#ifndef RP_BAR
#define RP_BAR 1
#endif
#ifndef MOE_FP8
#ifndef OUT_FP8
#define OUT_FP8 1
#endif
#ifndef PV_LATE_WAIT
#define PV_LATE_WAIT 1
#endif
#ifndef ATTN_NBUF
#define ATTN_NBUF 2
#endif
#ifndef ADA_KSPLIT
#define ADA_KSPLIT 1
#endif
#ifndef GL_BF16
#define GL_BF16 0
#endif
#ifndef MOE_GATHER
#define MOE_GATHER 1
#endif
#ifndef W_FILL
#define W_FILL 0
#endif
#ifndef ALIGN_F8
#define ALIGN_F8 ALIGN_PLAIN
#endif
#ifndef F8_SP2
#define F8_SP2 true
#endif
#define MOE_FP8 1
#endif
#define GAS __attribute__((address_space(1)))
#define LAS __attribute__((address_space(3)))
typedef unsigned short bf16_t;
#if OUT_FP8
typedef unsigned char MixT;
#else
typedef unsigned short MixT;
#endif
typedef short bf16x8 __attribute__((ext_vector_type(8)));
typedef short s16x4 __attribute__((ext_vector_type(4)));
typedef float f32x2 __attribute__((ext_vector_type(2)));
typedef float f32x4 __attribute__((ext_vector_type(4)));
typedef float f32x16 __attribute__((ext_vector_type(16)));
typedef unsigned u32x2 __attribute__((ext_vector_type(2)));
typedef unsigned u32x4 __attribute__((ext_vector_type(4)));

constexpr int DM = 2048, NB = 4, SEQ = 4096, CTXL = 256, DEPTH = 2;
constexpr int NLAT = NB * SEQ, NCTX = NB * CTXL, NTOK = NLAT + NCTX;
constexpr int DIN = 3680, DINP = 3840;
constexpr int ZC_CQ = 0, ZC_CKV = 512, ZC_KPE = 1024, ZC_ZU = 1088, ZC_ZV = 1600, ZC_GQ = 2112, ZC_GK = 2368, ZC_GV = 2624, ZC_GR = 3136, ZC_GGF = 3648, ZC_GGB = 3664;
constexpr int NH = 8, QKD = 192, NOPE = 128, ROPE = 64, VD = 128;
constexpr int QLD = NH * QKD  , VLD = NH * VD  ;
constexpr int GH = 4, GDK = 64, GDV = 128, GCH = 64, NCHUNK = (SEQ + CTXL) / GCH  ;
constexpr int NEXP = 16, DEXP = 1024;
constexpr float EPS = 1e-6f;
constexpr int MAXSLOT_TILES = 152, MAXSLOTS = MAXSLOT_TILES * 256;

constexpr size_t MiB = 1u << 20;
constexpr size_t WS_CTL = 0, CTL_ZERO_BYTES = ADA_KSPLIT ? (1u << 20) + 2 * 5 * 12288 * 4 : 64 * 1024;
constexpr size_t WS_MOD = 1 * MiB;
constexpr size_t WS_ROPE = WS_MOD + 512 * 1024;
constexpr size_t WS_RSQ = 2 * MiB;
constexpr size_t WS_TOKE = 4 * MiB;
constexpr size_t WS_TOKI = WS_TOKE + 256 * 1024;
constexpr size_t WS_TOKS = WS_TOKI + 256 * 1024;
constexpr size_t WS_CW = WS_TOKS + 256 * 1024;
constexpr size_t WS_LIST = WS_CW + 256 * 1024;
constexpr size_t WS_GLAM = 6 * MiB;
constexpr size_t WS_W = 8 * MiB;
constexpr size_t WEB = MOE_FP8 ? 1 : 2;
constexpr size_t W_IN = 0;
constexpr size_t W_UQ = W_IN + (size_t)DINP * DM * 2;
constexpr size_t W_UKV = W_UQ + (size_t)2048 * 512 * 2;
constexpr size_t W_OUT = W_UKV + (size_t)2048 * 512 * 2;
constexpr size_t W_GU = W_OUT + (size_t)2048 * 2048 * 2;
constexpr size_t W_2 = W_GU + (size_t)NEXP * 2048 * 2048 * WEB;
constexpr size_t W_SGU = W_2 + (size_t)NEXP * 2048 * 1024 * WEB;
constexpr size_t W_BYTES = W_SGU + (size_t)4 * 128 * 128 * 2;
constexpr size_t WL_BYTES = ((W_BYTES + MiB - 1) / MiB) * MiB;
constexpr size_t WS_X1 = WS_W + DEPTH * WL_BYTES;
constexpr size_t XBYTES = (size_t)NTOK * DM * 4;
constexpr size_t WS_X2 = WS_X1 + XBYTES;
constexpr size_t WS_H = WS_X2 + XBYTES;
constexpr size_t WS_R = WS_H + (size_t)NTOK * DM * 2;
constexpr size_t R_Z = 0;
constexpr size_t R_Q = R_Z + (size_t)NTOK * DINP * 2;
constexpr size_t R_K = R_Q + (size_t)NTOK * QLD * 2;
constexpr size_t R_V = R_K + (size_t)NTOK * QLD * 2;
constexpr size_t R_MIX = R_V + (size_t)NTOK * VLD * 2;
constexpr size_t GSTATE_ELEMS = (size_t)NB * NCHUNK * GH * 2 * GDV * GDK;
constexpr size_t R_GL = R_MIX + (size_t)NTOK * DM * 2;
constexpr size_t R_GS = R_GL + GSTATE_ELEMS * 4;
constexpr size_t R_GQK = R_GS + GSTATE_ELEMS * 2;
constexpr size_t R_GVT = R_GQK + (size_t)NB * NCHUNK * GH * 4 * 64 * 64 * 2;
constexpr size_t R_END_MIX = R_GVT + (size_t)NB * NCHUNK * GH * 128 * 64 * 2;
constexpr size_t R_H2S = 0;
constexpr size_t R_ACT = R_H2S + (size_t)MAXSLOTS * DM * 2;
constexpr size_t R_Y = R_ACT + (size_t)MAXSLOTS * DEXP * 2;
constexpr size_t R_END_MOE = R_Y + (size_t)MAXSLOTS * DM * 2;
constexpr size_t WS_END = WS_R + (R_END_MIX > R_END_MOE ? R_END_MIX : R_END_MOE);
static_assert(WS_END < 1250ull * 1000 * 1000, "workspace map must fit under sum(inputs)");
constexpr int CW_BAR = 1024;
constexpr int CW_CNT = 8192;
constexpr int CW_Q = 8192 + 256;
static_assert((CW_BAR + 3456) <= CW_CNT && (CW_Q + 64 * 8) * 4 <= 64 * 1024, "ctl map");

constexpr int RING_BYTES = 131072;
constexpr int SCR_OFF = RING_BYTES;
constexpr int SCR_BYTES = 16384;
constexpr int MISC_OFF = (ATTN_NBUF == 3) ? 154 * 1024 : SCR_OFF + SCR_BYTES;
constexpr int LDS_BYTES = MISC_OFF + 256;

__device__ __forceinline__ unsigned cvt_pk_bf16(float lo, float hi) { unsigned r; asm("v_cvt_pk_bf16_f32 %0, %1, %2" : "=v"(r) : "v"(lo), "v"(hi)); return r; }
__device__ __forceinline__ unsigned f2bf(float f) { return cvt_pk_bf16(f, f) & 0xffffu; }
__device__ __forceinline__ unsigned pk2(float lo, float hi) { return cvt_pk_bf16(lo, hi); }
__device__ __forceinline__ unsigned f2bf_sw(float f) { unsigned u = __float_as_uint(f); u += 0x7FFFu + ((u >> 16) & 1u); return u >> 16; }
__device__ __forceinline__ float bf2f(unsigned short b) { return __builtin_bit_cast(float, ((unsigned)b) << 16); }
__device__ __forceinline__ float bflo(unsigned w) { return __builtin_bit_cast(float, w << 16); }
__device__ __forceinline__ float bfhi(unsigned w) { return __builtin_bit_cast(float, w & 0xffff0000u); }
__device__ __forceinline__ unsigned pk4_fp8(float a, float b, float c, float d) { int w = __builtin_amdgcn_cvt_pk_fp8_f32(a, b, 0, false); w = __builtin_amdgcn_cvt_pk_fp8_f32(c, d, w, true); return (unsigned)w; }
__device__ __forceinline__ unsigned pk2_fp8(float a, float b) { return (unsigned)__builtin_amdgcn_cvt_pk_fp8_f32(a, b, 0, false) & 0xFFFFu; }
__device__ __forceinline__ float clamp8(float x) { return fminf(fmaxf(x, -448.0f), 448.0f); }
constexpr float W8_SCALE = 32.0f;
__device__ __forceinline__ float wave_sum(float v) {
#pragma unroll
    for (int o = 1; o < 64; o <<= 1) v += __shfl_xor(v, o);
    return v;
}
__device__ __forceinline__ float silu_f(float x) { return x / (1.f + __expf(-x)); }
__device__ __forceinline__ float gelu_tanh_f(float x) {
    const float u = 0.7978845608028654f * (x + 0.044715f * x * x * x);
    return x / (1.f + __expf(-2.f * u));
}
__device__ __forceinline__ float logsigmoid_f(float x) { return fminf(x, 0.f) - log1pf(__expf(-fabsf(x))); }
#define LDS_WAIT() asm volatile("s_waitcnt lgkmcnt(0)" ::: "memory")
__device__ __forceinline__ void lds_barrier() { asm volatile("s_waitcnt lgkmcnt(0)" ::: "memory"); __builtin_amdgcn_s_barrier(); asm volatile("" ::: "memory"); }
#define VM_WAIT() asm volatile("s_waitcnt vmcnt(0)" ::: "memory")

__device__ __forceinline__ int mod_row_of(int row) { return row < NLAT ? (row >> 12) : 4; }
__device__ __forceinline__ int lane_id() { int l; asm volatile("v_mbcnt_lo_u32_b32 %0, -1, 0\n\tv_mbcnt_hi_u32_b32 %0, -1, %0" : "=v"(l)); return l; }
#define XB_TMO      128
#define XB_XCNT(j)  (256  + 64 * (j))
#define XB_XSUB(j)  (1280 + 64 * (j))
#define XB_XGEN(j)  (2304 + 64 * (j))
#define XB_TOP      3328
#define XB_TOPGEN   3392
#define XCD_BAR_WORDS 3456
#define XB_SPIN_CAP (1u << 18)
#define LAS __attribute__((address_space(3)))

__device__ __forceinline__ unsigned xb_ld(unsigned* p)              { return __hip_atomic_load(p, __ATOMIC_RELAXED, __HIP_MEMORY_SCOPE_AGENT); }
__device__ __forceinline__ unsigned xb_add(unsigned* p, unsigned v) { return __hip_atomic_fetch_add(p, v, __ATOMIC_RELAXED, __HIP_MEMORY_SCOPE_AGENT); }
__device__ __forceinline__ unsigned xb_xcc_id() { return (unsigned)__builtin_amdgcn_s_getreg((3 << 11) | 20) & 0xFu; }
#define XB_SPIN(cond, bar) do { unsigned _sp = 0; while (cond) { __builtin_amdgcn_s_sleep(1); \
    if ((++_sp & 255u) == 0u) { if (xb_ld(&(bar)[XB_TMO])) break; if (_sp > XB_SPIN_CAP) { atomicAdd(&(bar)[XB_TMO], 1u); break; } } } } while (0)

struct XcdBarrier {
    unsigned* bar; unsigned x;
    volatile LAS unsigned* st;
};

__device__ __forceinline__ XcdBarrier xcd_barrier_post(unsigned* bar, volatile LAS unsigned* st) {
    XcdBarrier b; b.bar = bar; b.x = xb_xcc_id(); b.st = st;
    if (threadIdx.x == 0) (void)xb_add(&bar[XB_XCNT(b.x)], 1u);
    return b;
}
__device__ __forceinline__ void xcd_barrier_complete(unsigned* bar, unsigned x, unsigned& nloc, unsigned& nx) {
    const unsigned G = gridDim.x * gridDim.y * gridDim.z;
    unsigned sum, cnt, mine, sp = 0u;
    for (;;) {
        sum = 0u; cnt = 0u; mine = 0u;
#pragma unroll
        for (unsigned j = 0; j < 16; ++j) { const unsigned c = xb_ld(&bar[XB_XCNT(j)]); sum += c; cnt += (c > 0u) ? 1u : 0u; mine = (j == x) ? c : mine; }
        if (sum == G) break;
        __builtin_amdgcn_s_sleep(1);
        if ((++sp & 255u) == 0u) { if (xb_ld(&bar[XB_TMO])) break; if (sp > XB_SPIN_CAP) { atomicAdd(&bar[XB_TMO], 1u); break; } }
    }
    nloc = mine > 0u ? mine : 1u; nx = cnt > 0u ? cnt : 1u;
}

__device__ __forceinline__ void xcd_barrier(const XcdBarrier& b) {
    asm volatile("s_waitcnt vmcnt(0)" ::: "memory");
    __syncthreads();
    if (threadIdx.x == 0) {
        unsigned* bar = b.bar;
        __builtin_amdgcn_s_waitcnt(0);
        unsigned nloc = b.st[0], nx = b.st[1];
        if (nloc == 0u) { xcd_barrier_complete(bar, b.x, nloc, nx); b.st[0] = nloc; b.st[1] = nx; }
        const unsigned old = xb_add(&bar[XB_XSUB(b.x)], 1u);
        const unsigned gen = old / nloc;
        if (old + 1u == (gen + 1u) * nloc) {
            __builtin_amdgcn_fence(__ATOMIC_RELEASE, "agent");
            asm volatile("s_waitcnt vmcnt(0)" ::: "memory");
            const unsigned og = xb_add(&bar[XB_TOP], 1u);
            const unsigned tg = og / nx;
            if (og + 1u == (tg + 1u) * nx) xb_add(&bar[XB_TOPGEN], 1u);
            else XB_SPIN(xb_ld(&bar[XB_TOPGEN]) == tg, bar);
            __builtin_amdgcn_fence(__ATOMIC_ACQUIRE, "agent");
            xb_add(&bar[XB_XGEN(b.x)], 1u);
            asm volatile("s_waitcnt vmcnt(0)" ::: "memory");
        } else {
            XB_SPIN(xb_ld(&bar[XB_XGEN(b.x)]) == gen, bar);
            __builtin_amdgcn_fence(__ATOMIC_ACQUIRE, "agent");
            asm volatile("s_waitcnt vmcnt(0)" ::: "memory");
        }
    }
    __syncthreads();
}

namespace pg8 {
constexpr int BM = 256, BK = 64, HALF = 128, HTB = HALF * BK * 2  , STAGE_BYTES = 8 * HTB;
static_assert(STAGE_BYTES == RING_BYTES, "ring");
__host__ __device__ __forceinline__ int lds_byte(int r, int c) { const int st = (r >> 4) * 2 + (c >> 5), rr = r & 15, cc = c & 31, ob = rr * 64 + cc * 2; return st * 1024 + (ob ^ (((ob >> 9) & 1) << 5)); }
__host__ __device__ __forceinline__ void stage_rc(int b, int& R, int& C) { const int st = b / 1024, sb = b % 1024, swz = sb ^ (((sb >> 9) & 1) << 5); R = (st >> 1) * 16 + swz / 64; C = (st & 1) * 32 + (swz % 64) / 2; }
__host__ __device__ __forceinline__ int perm32(int rho) { const int n = rho >> 4, i = rho & 15; return 8 * (i >> 2) + 4 * n + (i & 3); }

struct Unit { int pm, pn, aux; };

#ifndef PG8_SP2
#define PG8_SP2 true
#endif
typedef int v8i __attribute__((ext_vector_type(8)));
typedef int i32x4_ __attribute__((ext_vector_type(4)));
template <class Epi, class Sched, bool F8 = false, bool ALIGN_EPI = true, bool SP2 = PG8_SP2>
__device__ __forceinline__ void gemm_phase(const int tid, LAS unsigned char* lds, LAS unsigned char* scr, const int ldaB, const int KB, const Sched& S, const Epi& E) {
    const int wid = __builtin_amdgcn_readfirstlane(tid >> 6), lane = tid & 63, wr = wid >> 2, wc = wid & 3, fr = lane & 15, fq = lane >> 4;
    const int nt = KB / 128;
    constexpr bool GA = Sched::GATHER;
    static_assert(!GA || SP2, "gather: SP2 schedule only");
    unsigned voffA[2], voffB[2]; int gR[2];
#pragma unroll
    for (int i = 0; i < 2; ++i) { int R, C; stage_rc(tid * 16 + i * 8192, R, C); const int Rb = Epi::PERM ? ((R & ~31) + perm32(R & 31)) : R;
        voffA[i] = GA ? (unsigned)(C * 2) : (unsigned)(R * ldaB + C * 2); voffB[i] = (unsigned)(Rb * KB + C * 2); gR[i] = R; }
    unsigned gC[2][2], gN[2][2];
#define PG8_GFETCH(g, uidx) do { if constexpr (GA) { _Pragma("unroll") for (int h_ = 0; h_ < 2; ++h_) _Pragma("unroll") for (int i_ = 0; i_ < 2; ++i_) g[h_][i_] = S.gtab[(uidx) * 256 + h_ * 128 + gR[i_]] + voffA[i_]; } } while (0)
#define PG8_STAGE_A(bufoff, soff, h, koff) do { if constexpr (GA) PG8_STAGE(bufoff, rsA, koff, gC[h]); else PG8_STAGE(bufoff, rsA, soff, voffA); } while (0)
    const unsigned kstep = 128u;
    const unsigned hA = (unsigned)HALF * ldaB, hB = (unsigned)HALF * KB;
    const __amdgpu_buffer_rsrc_t rsA = __builtin_amdgcn_make_buffer_rsrc((void*)S.a_base(), 0, 0x7ffffff0, 0x00020000), rsB = __builtin_amdgcn_make_buffer_rsrc((void*)S.b_base(), 0, 0x7ffffff0, 0x00020000);
    const unsigned ldsw = (unsigned)wid * 1024u;
    const int aoff = F8 ? lds_byte(wr * 64 + fr, fq * 16) : lds_byte(wr * 64 + fr, fq * 8), boff = F8 ? lds_byte(wc * 32 + fr, fq * 16) : lds_byte(wc * 32 + fr, fq * 8);
    const int aoff1 = lds_byte(wr * 64 + fr, fq * 16 + 8), boff1 = lds_byte(wc * 32 + fr, fq * 16 + 8);
#define PG8_SA(b, h) (((b) * 2 + (h)) * HTB)
#define PG8_SB(b, h) ((4 + (b) * 2 + (h)) * HTB)
#define PG8_STAGE(bufoff, rs, soff, voff) do { _Pragma("unroll") for (int _i = 0; _i < 2; ++_i) { \
        if constexpr (Sched::B_NT) { if (&(voff) == &voffB) __builtin_amdgcn_raw_ptr_buffer_load_lds(rs, (LAS void*)(lds + (bufoff) + ldsw + _i * 8192), 16, (int)(voff)[_i], (int)(soff), 0, 2); \
                                     else __builtin_amdgcn_raw_ptr_buffer_load_lds(rs, (LAS void*)(lds + (bufoff) + ldsw + _i * 8192), 16, (int)(voff)[_i], (int)(soff), 0, 0); } \
        else __builtin_amdgcn_raw_ptr_buffer_load_lds(rs, (LAS void*)(lds + (bufoff) + ldsw + _i * 8192), 16, (int)(voff)[_i], (int)(soff), 0, 0); } } while (0)
#define PG8_LDA(dst, b, h) do { _Pragma("unroll") for (int m = 0; m < 4; ++m) { dst[m][0] = *(const LAS bf16x8*)(lds + PG8_SA(b, h) + aoff + m * 2048); \
        dst[m][1] = *(const LAS bf16x8*)(lds + PG8_SA(b, h) + (F8 ? aoff1 : aoff + 1024) + m * 2048); } } while (0)
#define PG8_LDB(dst, b, h) do { _Pragma("unroll") for (int n = 0; n < 2; ++n) { dst[n][0] = *(const LAS bf16x8*)(lds + PG8_SB(b, h) + boff + n * 2048); \
        dst[n][1] = *(const LAS bf16x8*)(lds + PG8_SB(b, h) + (F8 ? boff1 : boff + 1024) + n * 2048); } } while (0)
#define PG8_V8(X) __builtin_shufflevector(__builtin_bit_cast(i32x4_, X[0]), __builtin_bit_cast(i32x4_, X[1]), 0, 1, 2, 3, 4, 5, 6, 7)
#define PG8_MMA(ai, bj, At, Bt) do { if constexpr (F8) __builtin_amdgcn_sched_barrier(0); __builtin_amdgcn_s_setprio(1); _Pragma("unroll") for (int m = 0; m < 4; ++m) _Pragma("unroll") for (int n = 0; n < 2; ++n) { \
        if constexpr (F8) acc[ai][bj][m][n] = __builtin_amdgcn_mfma_scale_f32_16x16x128_f8f6f4(PG8_V8(Bt[n]), PG8_V8(At[m]), acc[ai][bj][m][n], 0, 0, 0, 0x7A7A7A7A, 0, 0x7F7F7F7F); \
        else { _Pragma("unroll") for (int k = 0; k < 2; ++k) acc[ai][bj][m][n] = __builtin_amdgcn_mfma_f32_16x16x32_bf16(Bt[n][k], At[m][k], acc[ai][bj][m][n], 0, 0, 0); } } \
        if constexpr (F8) __builtin_amdgcn_sched_barrier(0); __builtin_amdgcn_s_setprio(0); if constexpr (F8) __builtin_amdgcn_sched_barrier(0); } while (0)
#define PG8_WAIT_V(n) asm volatile("s_waitcnt vmcnt(" #n ")" ::: "memory")
#define PG8_WAIT_L(n) asm volatile("s_waitcnt lgkmcnt(" #n ")" ::: "memory")
#define PG8_BAR __builtin_amdgcn_s_barrier()
#define PG8_SCHED __builtin_amdgcn_sched_barrier(0)
    Unit cur, nxt; int ui = 0;
    if (!S.next(0, cur)) return;
    f32x4 acc[2][2][4][2];
#pragma unroll
    for (int a = 0; a < 2; ++a)
#pragma unroll
        for (int b = 0; b < 2; ++b)
#pragma unroll
            for (int m = 0; m < 4; ++m)
#pragma unroll
                for (int n = 0; n < 2; ++n) acc[a][b][m][n] = (f32x4){0.f, 0.f, 0.f, 0.f};
    bf16x8 At[4][2], B0[2][2], B1[2][2];
    unsigned cA = S.a_off(cur), cB = S.b_off(cur);
    if constexpr (SP2) {
        PG8_GFETCH(gC, 0);
        PG8_STAGE(PG8_SB(0, 0), rsB, cB, voffB); PG8_STAGE(PG8_SB(0, 1), rsB, cB + hB, voffB); PG8_STAGE_A(PG8_SA(0, 0), cA, 0, 0u); PG8_STAGE_A(PG8_SA(0, 1), cA + hA, 1, 0u);
        if (wr == 1) PG8_BAR;
        PG8_WAIT_V(2); PG8_BAR;
        PG8_STAGE(PG8_SB(1, 0), rsB, cB + kstep, voffB); PG8_STAGE_A(PG8_SA(1, 0), cA + kstep, 0, kstep); PG8_STAGE(PG8_SB(1, 1), rsB, cB + hB + kstep, voffB);
        PG8_WAIT_V(6); PG8_BAR;
    } else {
        PG8_STAGE(PG8_SB(0, 0), rsB, cB, voffB); PG8_STAGE(PG8_SA(0, 0), rsA, cA, voffA); PG8_STAGE(PG8_SB(0, 1), rsB, cB + hB, voffB); PG8_STAGE(PG8_SA(0, 1), rsA, cA + hA, voffA);
        if (wr == 1) PG8_BAR;
        PG8_WAIT_V(4); PG8_BAR;
        PG8_STAGE(PG8_SB(1, 0), rsB, cB + kstep, voffB); PG8_STAGE(PG8_SA(1, 0), rsA, cA + kstep, voffA); PG8_STAGE(PG8_SB(1, 1), rsB, cB + hB + kstep, voffB);
        PG8_WAIT_V(6); PG8_BAR;
    }
    for (;;) {
        const bool has_next = S.next(ui + 1, nxt);
        const unsigned nA = has_next ? S.a_off(nxt) : cA, nB = has_next ? S.b_off(nxt) : cB;
        PG8_GFETCH(gN, has_next ? ui + 1 : ui);
#pragma nounroll
        for (int t = 0; t < nt; t += 2) {
            const bool last = (t == nt - 2);
            const unsigned a1 = cA + (unsigned)(t + 1) * kstep;
            const unsigned a2 = last ? nA : cA + (unsigned)(t + 2) * kstep, b2 = last ? nB : cB + (unsigned)(t + 2) * kstep;
            const unsigned a3 = a2 + kstep, b3 = b2 + kstep;
            const unsigned k1 = (unsigned)(t + 1) * kstep, k2 = last ? 0u : (unsigned)(t + 2) * kstep, k3 = k2 + kstep;
            if constexpr (SP2) {
            PG8_LDB(B0, 0, 0); PG8_LDB(B1, 0, 1); PG8_SCHED; PG8_LDA(At, 0, 0); PG8_STAGE_A(PG8_SA(1, 1), a1 + hA, 1, k1);
            if constexpr (GA) { if (last) { gC[0][0] = gN[0][0]; gC[0][1] = gN[0][1]; gC[1][0] = gN[1][0]; gC[1][1] = gN[1][1]; } }
            PG8_WAIT_V(8); PG8_WAIT_L(0); PG8_BAR; PG8_MMA(0, 0, At, B0); PG8_MMA(0, 1, At, B1); PG8_BAR; PG8_SCHED;
            PG8_LDA(At, 0, 1); PG8_STAGE(PG8_SB(0, 0), rsB, b2, voffB); PG8_STAGE(PG8_SB(0, 1), rsB, b2 + hB, voffB); PG8_STAGE_A(PG8_SA(0, 0), a2, 0, k2);
            PG8_WAIT_V(8); PG8_WAIT_L(0); PG8_BAR; PG8_MMA(1, 0, At, B0); PG8_MMA(1, 1, At, B1); PG8_BAR; PG8_SCHED;
            PG8_LDB(B0, 1, 0); PG8_LDB(B1, 1, 1); PG8_SCHED; PG8_LDA(At, 1, 0); PG8_STAGE_A(PG8_SA(0, 1), a2 + hA, 1, k2);
            PG8_WAIT_V(8); PG8_WAIT_L(0); PG8_BAR; PG8_MMA(0, 0, At, B0); PG8_MMA(0, 1, At, B1); PG8_BAR; PG8_SCHED;
            PG8_LDA(At, 1, 1); PG8_STAGE(PG8_SB(1, 0), rsB, b3, voffB); PG8_STAGE(PG8_SB(1, 1), rsB, b3 + hB, voffB); PG8_STAGE_A(PG8_SA(1, 0), a3, 0, k3);
            PG8_WAIT_V(8); PG8_WAIT_L(0); PG8_BAR; PG8_MMA(1, 0, At, B0); PG8_MMA(1, 1, At, B1); PG8_BAR; PG8_SCHED;
            } else {
            PG8_LDB(B0, 0, 0); PG8_SCHED; PG8_LDA(At, 0, 0); PG8_STAGE(PG8_SA(1, 1), rsA, a1 + hA, voffA);
            PG8_WAIT_L(8); PG8_BAR; PG8_WAIT_L(0); PG8_MMA(0, 0, At, B0); PG8_BAR; PG8_SCHED;
            PG8_LDB(B1, 0, 1); PG8_STAGE(PG8_SB(0, 0), rsB, b2, voffB);
            PG8_BAR; PG8_WAIT_L(0); PG8_MMA(0, 1, At, B1); PG8_BAR;
            PG8_LDA(At, 0, 1); PG8_STAGE(PG8_SA(0, 0), rsA, a2, voffA);
            PG8_BAR; PG8_WAIT_L(0); PG8_MMA(1, 0, At, B0); PG8_BAR; PG8_SCHED;
            PG8_STAGE(PG8_SB(0, 1), rsB, b2 + hB, voffB);
            PG8_WAIT_V(6); PG8_BAR; PG8_MMA(1, 1, At, B1); PG8_BAR;
            PG8_LDB(B0, 1, 0); PG8_SCHED; PG8_LDA(At, 1, 0); PG8_STAGE(PG8_SA(0, 1), rsA, a2 + hA, voffA);
            PG8_WAIT_L(8); PG8_BAR; PG8_WAIT_L(0); PG8_MMA(0, 0, At, B0); PG8_BAR; PG8_SCHED;
            PG8_LDB(B1, 1, 1); PG8_STAGE(PG8_SB(1, 0), rsB, b3, voffB);
            PG8_BAR; PG8_WAIT_L(0); PG8_MMA(0, 1, At, B1); PG8_BAR;
            PG8_LDA(At, 1, 1); PG8_STAGE(PG8_SA(1, 0), rsA, a3, voffA);
            PG8_BAR; PG8_WAIT_L(0); PG8_MMA(1, 0, At, B0); PG8_BAR; PG8_SCHED;
            PG8_STAGE(PG8_SB(1, 1), rsB, b3 + hB, voffB);
            PG8_WAIT_V(6); PG8_BAR; PG8_MMA(1, 1, At, B1); PG8_BAR;
            }
        }
        if constexpr (ALIGN_EPI) { if (wr == 0) PG8_BAR; }
        for (int re_ = 0; re_ < (Epi::PROBE_REP ? RP_EPI : 1); ++re_) { asm volatile("" ::: "memory"); const int l2 = lane_id(); E(acc, cur, wr, wc, l2 & 15, l2 >> 4, scr); }
        if (!has_next) break;
#pragma unroll
        for (int a = 0; a < 2; ++a)
#pragma unroll
            for (int b = 0; b < 2; ++b)
#pragma unroll
                for (int m = 0; m < 4; ++m)
#pragma unroll
                    for (int n = 0; n < 2; ++n) acc[a][b][m][n] = (f32x4){0.f, 0.f, 0.f, 0.f};
        cur = nxt; cA = nA; cB = nB; ++ui;
        if constexpr (ALIGN_EPI) { if (wr == 1) PG8_BAR; }
    }
    PG8_WAIT_V(0);
    if constexpr (!ALIGN_EPI) { if (wr == 0) PG8_BAR; }
    PG8_BAR;
#undef PG8_SA
#undef PG8_SB
#undef PG8_STAGE
#undef PG8_STAGE_A
#undef PG8_GFETCH
#undef PG8_LDA
#undef PG8_LDB
#undef PG8_MMA
#undef PG8_V8
#undef PG8_WAIT_V
#undef PG8_WAIT_L
#undef PG8_BAR
#undef PG8_SCHED
}
}

struct Params { const float* in[31]; float* out; unsigned char* ws; int ph_lo, ph_hi; };
typedef const Params __attribute__((address_space(4)))* KP;
__device__ __forceinline__ KP kparams() { KP q = (KP)__builtin_amdgcn_kernarg_segment_ptr(); asm volatile("" : "+s"(q)); return q; }
enum { I_X = 0, I_C, I_CTX, I_CCTX, I_N1G, I_N2G, I_ADAW, I_ADAB, I_WIN, I_QNORM, I_WUQ, I_KVNORM, I_WUKV, I_QGAIN, I_KGAIN, I_SGUNORM, I_SGUW, I_SGUB,
       I_WGF, I_BGF, I_WGB, I_BGB, I_GLAON, I_WOUT, I_MWG, I_MBG, I_MWE, I_MBE, I_MW1, I_MW3, I_MW2 };

struct TileSched { static constexpr bool B_NT = false, GATHER = false;
    const char* A; const char* Bt; size_t a_tile, b_tile;
    int nM, nN, nwg, G, c, rep;
    __device__ __forceinline__ void init(const void* A_, size_t lda, const void* Bt_, size_t K, int nM_, int nN_, int G_, int c_, int rep_ = 1) {
        A = (const char*)A_; Bt = (const char*)Bt_; a_tile = 256 * lda * 2; b_tile = 256 * K * 2; nM = nM_; nN = nN_; nwg = nM * nN; G = G_; c = c_; rep = rep_; }
    __device__ __forceinline__ bool next(int i, pg8::Unit& u) const {
        const long L = (long)i * G + c; if (L >= (long)nwg * rep) return false;
        int wgid = (int)(L % nwg); { const int q = nwg / 8, r = nwg % 8, xcd = wgid % 8, off = wgid / 8; wgid = (xcd < r ? xcd * (q + 1) : r * (q + 1) + (xcd - r) * q) + off; }
        const int nig = 8 * nN, gid = wgid / nig, fm = gid * 8, gsz = (nM - fm) < 8 ? (nM - fm) : 8;
        u.pm = fm + ((wgid % nig) % gsz); u.pn = (wgid % nig) / gsz; u.aux = 0; return true;
    }
    __device__ __forceinline__ const char* a_base() const { return A; }
    __device__ __forceinline__ const char* b_base() const { return Bt; }
    __device__ __forceinline__ unsigned a_off(const pg8::Unit& u) const { return (unsigned)u.pm * (unsigned)a_tile; }
    __device__ __forceinline__ unsigned b_off(const pg8::Unit& u) const { return (unsigned)u.pn * (unsigned)b_tile; }
};
struct UpSched { static constexpr bool B_NT = false, GATHER = false;
    const char* Z; const char* Wq; const char* Wkv; int nQ, ntot, G, c, rep;
    __device__ __forceinline__ bool next(int i, pg8::Unit& u) const {
        int L = i * G + c; if (L >= ntot * rep) return false; L %= ntot;
        u.aux = (L >= nQ) ? 1 : 0; const int nk = u.aux ? ntot - nQ : nQ; if (u.aux) L -= nQ;
        if (L < (nk & ~255)) { const int i = L >> 8, c = L & 255, xcd = c & 7, j = c >> 3; u.pm = 32 * i + 4 * xcd + (j >> 3); u.pn = j & 7; }
        else { u.pm = L >> 3; u.pn = L & 7; }
        return true;
    }
    __device__ __forceinline__ const char* a_base() const { return Z; }
    __device__ __forceinline__ const char* b_base() const { return Wq; }
    __device__ __forceinline__ unsigned a_off(const pg8::Unit& u) const { return (unsigned)u.pm * (256u * DINP * 2u) + (u.aux ? ZC_CKV * 2u : ZC_CQ * 2u); }
    __device__ __forceinline__ unsigned b_off(const pg8::Unit& u) const { return (u.aux ? (unsigned)(Wkv - Wq) : 0u) + (unsigned)u.pn * (256u * 512u * 2u); }
};
struct MoeSched { static constexpr bool B_NT = (MOE_BNT != 0), GATHER = false;
    const char* A; const char* W; size_t a_tile, w_exp, b_tile; const volatile LAS int* tstart; int ntot, G, c, rep;
    __device__ __forceinline__ bool next(int i, pg8::Unit& u) const {
        int L = i * G + c; if (L >= ntot * rep) return false; L %= ntot;
        if (G == 256 && L < (ntot & ~255)) { const int r_ = L >> 8, cc = L & 255, x = cc & 7, j = cc >> 3; u.pn = 4 * (x & 1) + (j & 3); u.pm = 32 * r_ + 8 * (x >> 1) + (j >> 2); }
        else { u.pm = L >> 3; u.pn = L & 7; }
        int e = 0;
#pragma unroll
        for (int j = 1; j < 16; ++j) e += (u.pm >= tstart[j]) ? 1 : 0;
        u.aux = __builtin_amdgcn_readfirstlane(e); return true;
    }
    __device__ __forceinline__ const char* a_base() const { return A; }
    __device__ __forceinline__ const char* b_base() const { return W; }
    __device__ __forceinline__ unsigned a_off(const pg8::Unit& u) const { return (unsigned)u.pm * (unsigned)a_tile; }
    __device__ __forceinline__ unsigned b_off(const pg8::Unit& u) const { return (unsigned)u.aux * (unsigned)w_exp + (unsigned)u.pn * (unsigned)b_tile; }
};

struct MoeSchedG : MoeSched { static constexpr bool GATHER = true; const LAS unsigned* gtab; };

typedef const f32x4 (&AccRef)[2][2][4][2];
struct EpiZ { static constexpr bool PERM = true, PROBE_REP = false;
    bf16_t* Z; float* rsq;
    __device__ __forceinline__ void operator()(AccRef acc, const pg8::Unit& u, int wr, int wc, int fr, int fq, LAS unsigned char*) const {
        const int row0 = u.pm * 256 + wr * 64 + fr, col0 = u.pn * 256 + wc * 32 + 8 * fq;
#pragma unroll
        for (int ai = 0; ai < 2; ++ai)
#pragma unroll
            for (int m = 0; m < 4; ++m) { const int row = row0 + ai * 128 + m * 16; bf16_t* rowp = Z + (size_t)row * DINP + col0; float ss = 0.f;
#pragma unroll
                for (int bj = 0; bj < 2; ++bj) { const f32x4 v0 = acc[ai][bj][m][0], v1 = acc[ai][bj][m][1];
                    ss += (v0[0] * v0[0] + v0[1] * v0[1]) + (v0[2] * v0[2] + v0[3] * v0[3]) + (v1[0] * v1[0] + v1[1] * v1[1]) + (v1[2] * v1[2] + v1[3] * v1[3]);
                    u32x4 w; w.x = cvt_pk_bf16(v0[0], v0[1]); w.y = cvt_pk_bf16(v0[2], v0[3]); w.z = cvt_pk_bf16(v1[0], v1[1]); w.w = cvt_pk_bf16(v1[2], v1[3]);
                    *(u32x4*)(rowp + bj * 128) = w; }
                if (u.pn < 4) { ss += __shfl_xor(ss, 16); ss += __shfl_xor(ss, 32); if (fq == 0) rsq[(size_t)row * 16 + u.pn * 4 + wc] = ss; } }
    }
};
struct EpiBf16 { static constexpr bool PERM = true, PROBE_REP = false;
    bf16_t* O; int ldc;
    __device__ __forceinline__ void operator()(AccRef acc, const pg8::Unit& u, int wr, int wc, int fr, int fq, LAS unsigned char*) const {
        const int row0 = u.pm * 256 + wr * 64 + fr, col0 = u.pn * 256 + wc * 32 + 8 * fq;
#pragma unroll
        for (int ai = 0; ai < 2; ++ai)
#pragma unroll
            for (int m = 0; m < 4; ++m) { bf16_t* rowp = O + (size_t)(row0 + ai * 128 + m * 16) * ldc + col0;
#pragma unroll
                for (int bj = 0; bj < 2; ++bj) { const f32x4 v0 = acc[ai][bj][m][0], v1 = acc[ai][bj][m][1];
                    u32x4 w; w.x = cvt_pk_bf16(v0[0], v0[1]); w.y = cvt_pk_bf16(v0[2], v0[3]); w.z = cvt_pk_bf16(v1[0], v1[1]); w.w = cvt_pk_bf16(v1[2], v1[3]);
                    *(u32x4*)(rowp + bj * 128) = w; } }
    }
};
struct EpiSwiglu { static constexpr bool PERM = true, PROBE_REP = false;
    unsigned char* ACT;
    __device__ __forceinline__ void operator()(AccRef acc, const pg8::Unit& u, int wr, int wc, int fr, int fq, LAS unsigned char*) const {
        const int row0 = u.pm * 256 + wr * 64 + fr, col0 = u.pn * 128 + wc * 32 + 8 * fq;
#pragma unroll
        for (int ai = 0; ai < 2; ++ai)
#pragma unroll
            for (int m = 0; m < 4; ++m) { unsigned char* rowp = ACT + ((size_t)(row0 + ai * 128 + m * 16) * DEXP + col0) * (MOE_FP8 ? 1 : 2);
                float o[8];
#pragma unroll
                for (int n = 0; n < 2; ++n)
#pragma unroll
                    for (int v = 0; v < 4; ++v) { const float g = acc[ai][0][m][n][v], up = acc[ai][1][m][n][v]; o[n * 4 + v] = silu_f(g) * up; }
#if MOE_FP8
                u32x2 w; w.x = pk4_fp8(o[0], o[1], o[2], o[3]); w.y = pk4_fp8(o[4], o[5], o[6], o[7]);
                *(u32x2*)rowp = w; }
#else
                u32x4 w; w.x = cvt_pk_bf16(o[0], o[1]); w.y = cvt_pk_bf16(o[2], o[3]); w.z = cvt_pk_bf16(o[4], o[5]); w.w = cvt_pk_bf16(o[6], o[7]);
                *(u32x4*)rowp = w; }
#endif
    }
};
template <bool RB>
struct EpiResid { static constexpr bool PERM = true, PROBE_REP = false;
    const void* xlat; const void* xctx; const float* mod; bf16_t* X1;
    __device__ __forceinline__ void operator()(AccRef acc, const pg8::Unit& u, int wr, int wc, int fr, int fq, LAS unsigned char*) const {
        const int row0 = u.pm * 256 + wr * 64 + fr, col0 = u.pn * 256 + wc * 32 + 8 * fq;
        const float* __restrict__ gate = mod + (size_t)(u.pm < 64 ? (u.pm >> 4) : 4) * (6 * DM) + 2 * DM + col0;
        const size_t roff = (u.pm < 64 ? (size_t)row0 * DM : (size_t)(row0 - NLAT) * DM) + col0;
        const char* __restrict__ rbase = (const char*)(u.pm < 64 ? xlat : xctx) + roff * (RB ? 2 : 4);
        bf16_t* __restrict__ obase = X1 + (size_t)row0 * DM + col0;
        f32x4 gv[2][2];
#pragma unroll
        for (int bj = 0; bj < 2; ++bj)
#pragma unroll
            for (int n = 0; n < 2; ++n) gv[bj][n] = *(const f32x4*)(gate + bj * 128 + n * 4);
        f32x4 rA[2][2], rB[2][2];
#define ER_LOAD(R, g) do { const char* rp = rbase + (size_t)(((g) >> 2) * 128 + ((g) & 3) * 16) * DM * (RB ? 2 : 4); _Pragma("unroll") for (int bj = 0; bj < 2; ++bj) { \
            if constexpr (RB) { const u32x4 w = __builtin_nontemporal_load((const u32x4*)(rp + bj * 256)); R[bj][0] = (f32x4){bflo(w.x), bfhi(w.x), bflo(w.y), bfhi(w.y)}; R[bj][1] = (f32x4){bflo(w.z), bfhi(w.z), bflo(w.w), bfhi(w.w)}; } \
            else { R[bj][0] = __builtin_nontemporal_load((const f32x4*)(rp + bj * 512)); R[bj][1] = __builtin_nontemporal_load((const f32x4*)(rp + bj * 512 + 16)); } } } while (0)
#define ER_STORE(R, g) do { bf16_t* op = obase + (size_t)(((g) >> 2) * 128 + ((g) & 3) * 16) * DM; _Pragma("unroll") for (int bj = 0; bj < 2; ++bj) { \
            const f32x4 o0 = R[bj][0] + gv[bj][0] * acc[(g) >> 2][bj][(g) & 3][0], o1 = R[bj][1] + gv[bj][1] * acc[(g) >> 2][bj][(g) & 3][1]; \
            u32x4 w; w.x = cvt_pk_bf16(o0[0], o0[1]); w.y = cvt_pk_bf16(o0[2], o0[3]); w.z = cvt_pk_bf16(o1[0], o1[1]); w.w = cvt_pk_bf16(o1[2], o1[3]); *(u32x4*)(op + bj * 128) = w; } } while (0)
        ER_LOAD(rA, 0);
#pragma unroll
        for (int g = 0; g < 8; g += 2) { ER_LOAD(rB, g + 1); ER_STORE(rA, g); if (g + 2 < 8) ER_LOAD(rA, g + 2); ER_STORE(rB, g + 1); }
#undef ER_LOAD
#undef ER_STORE
    }
};
struct EpiUp { static constexpr bool PERM = false, PROBE_REP = true;
    const bf16_t* Z; const float* rsq; const float* qgain; const float* kgain; const f32x2* rope; bf16_t* Q; bf16_t* K; bf16_t* V;
    __device__ __forceinline__ void operator()(AccRef acc, const pg8::Unit& u, int wr, int wc, int fr, int fq, LAS unsigned char* scr) const {
        LAS float* part = (LAS float*)scr;
        const int kind = u.aux, head = u.pn;
        const int rl0 = wr * 64 + fr;
        const bool ropecols = (wc < 2);
        float rs[2][4];
        float ss[2][4];
#pragma unroll
        for (int ai = 0; ai < 2; ++ai)
#pragma unroll
            for (int m = 0; m < 4; ++m) { const int row = u.pm * 256 + rl0 + ai * 128 + m * 16;
                const f32x4* rp = (const f32x4*)(rsq + (size_t)row * 16 + (kind ? 8 : 0)); const f32x4 a = rp[0], b = rp[1];
                const float tot = ((a[0] + a[1]) + (a[2] + a[3])) + ((b[0] + b[1]) + (b[2] + b[3]));
                const float r = 1.0f / sqrtf(tot * (1.0f / 512.0f) + EPS); rs[ai][m] = r;
                float s = 0.f;
#pragma unroll
                for (int n = 0; n < 2; ++n) { const f32x4 v = acc[ai][0][m][n]; s += (v[0] * v[0] + v[1] * v[1]) + (v[2] * v[2] + v[3] * v[3]); }
                if (kind == 0) { if (ropecols) {
#pragma unroll
                        for (int n = 0; n < 2; ++n) { const f32x4 v = acc[ai][1][m][n]; s += (v[0] * v[0] + v[1] * v[1]) + (v[2] * v[2] + v[3] * v[3]); } }
                    s *= r * r;
                } else { s *= r * r;
                    if (ropecols) {
#pragma unroll
                        for (int n = 0; n < 2; ++n) { const u32x2 w = *(const u32x2*)(Z + (size_t)row * DINP + ZC_KPE + 32 * wc + 16 * n + 4 * fq);
                            const float x0 = bflo(w.x), x1 = bfhi(w.x), x2 = bflo(w.y), x3 = bfhi(w.y); s += (x0 * x0 + x1 * x1) + (x2 * x2 + x3 * x3); } } }
                s += __shfl_xor(s, 16); s += __shfl_xor(s, 32);
                if (fq == 0) part[(rl0 + ai * 128 + m * 16) * 4 + wc] = s; }
        asm volatile("s_waitcnt lgkmcnt(0)" ::: "memory"); __builtin_amdgcn_s_barrier(); asm volatile("" ::: "memory");
#pragma unroll
        for (int ai = 0; ai < 2; ++ai)
#pragma unroll
            for (int m = 0; m < 4; ++m) { const f32x4 p4 = *(const LAS f32x4*)(part + (rl0 + ai * 128 + m * 16) * 4);
                ss[ai][m] = 1.0f / sqrtf(((p4[0] + p4[1]) + (p4[2] + p4[3])) * (1.0f / 192.0f) + EPS); }
        const float* gain = kind ? kgain : qgain;
        f32x4 g0[2], g1[2];
#pragma unroll
        for (int n = 0; n < 2; ++n) { g0[n] = *(const f32x4*)(gain + 32 * wc + 16 * n + 4 * fq); g1[n] = ropecols ? *(const f32x4*)(gain + 128 + 32 * wc + 16 * n + 4 * fq) : (f32x4){0.f, 0.f, 0.f, 0.f}; }
        u32x2 kA[2], kB[2]; f32x2 cA[4], cB[4];
#define EU_LOAD(KX, CX, g) do { const int row_ = u.pm * 256 + rl0 + ((g) >> 2) * 128 + ((g) & 3) * 16; \
            if (kind && ropecols) { KX[0] = *(const u32x2*)(Z + (size_t)row_ * DINP + ZC_KPE + 32 * wc + 4 * fq); KX[1] = *(const u32x2*)(Z + (size_t)row_ * DINP + ZC_KPE + 32 * wc + 16 + 4 * fq); } \
            if (ropecols && row_ < NLAT) { const int t_ = row_ & (SEQ - 1); const int pos_ = (wc == 0) ? (t_ >> 6) : (t_ & 63); const f32x2* cs_ = rope + pos_ * 16 + 4 * fq; \
                _Pragma("unroll") for (int v = 0; v < 4; ++v) CX[v] = cs_[v]; } } while (0)
#define EU_STORE(KX, CX, g) do { const int ai = (g) >> 2, m = (g) & 3; const int row = u.pm * 256 + rl0 + ai * 128 + m * 16; const float sc = rs[ai][m] * ss[ai][m]; \
            bf16_t* qk = (kind ? K : Q) + (size_t)row * QLD + head * QKD; \
            _Pragma("unroll") for (int n = 0; n < 2; ++n) { const f32x4 v = acc[ai][0][m][n] * sc * g0[n]; u32x2 w; w.x = cvt_pk_bf16(v[0], v[1]); w.y = cvt_pk_bf16(v[2], v[3]); \
                *(u32x2*)(qk + 32 * wc + 16 * n + 4 * fq) = w; } \
            if (kind) { bf16_t* vp = V + (size_t)row * VLD + head * VD; \
                _Pragma("unroll") for (int n = 0; n < 2; ++n) { const f32x4 v = acc[ai][1][m][n] * rs[ai][m]; u32x2 w; w.x = cvt_pk_bf16(v[0], v[1]); w.y = cvt_pk_bf16(v[2], v[3]); \
                    *(u32x2*)(vp + 32 * wc + 16 * n + 4 * fq) = w; } } \
            if (ropecols) { f32x4 u1, u2; \
                if (kind == 0) { u1 = acc[ai][1][m][0] * sc * g1[0]; u2 = acc[ai][1][m][1] * sc * g1[1]; } \
                else { const u32x2 a = KX[0], b = KX[1]; const float s2 = ss[ai][m]; \
                    u1 = (f32x4){bflo(a.x), bfhi(a.x), bflo(a.y), bfhi(a.y)} * s2 * g1[0]; u2 = (f32x4){bflo(b.x), bfhi(b.x), bflo(b.y), bfhi(b.y)} * s2 * g1[1]; } \
                if (row < NLAT) { f32x4 o1, o2; \
                    _Pragma("unroll") for (int v = 0; v < 4; ++v) { const f32x2 c = CX[v]; o1[v] = u1[v] * c.x - u2[v] * c.y; o2[v] = u1[v] * c.y + u2[v] * c.x; } \
                    u1 = o1; u2 = o2; } \
                u32x2 w; w.x = cvt_pk_bf16(u1[0], u1[1]); w.y = cvt_pk_bf16(u1[2], u1[3]); *(u32x2*)(qk + 128 + 32 * wc + 4 * fq) = w; \
                w.x = cvt_pk_bf16(u2[0], u2[1]); w.y = cvt_pk_bf16(u2[2], u2[3]); *(u32x2*)(qk + 128 + 32 * wc + 16 + 4 * fq) = w; } } while (0)
        EU_LOAD(kA, cA, 0);
#pragma unroll
        for (int g = 0; g < 8; g += 2) { EU_LOAD(kB, cB, g + 1); EU_STORE(kA, cA, g); if (g + 2 < 8) EU_LOAD(kA, cA, g + 2); EU_STORE(kB, cB, g + 1); }
#undef EU_LOAD
#undef EU_STORE
    }
};

struct Frame {
    LAS unsigned char* lds; LAS unsigned char* scr; volatile LAS unsigned* MISC;
    int tid, lane, wave, G, bid;
    unsigned char* ws; unsigned* ctl;
};

__device__ __forceinline__ void tr_item(const float* W, int N, int k0, int n0, bf16_t* WT, int ldk, int dst_row0, const float* kscale, LAS unsigned* scr, int lane) {
    const int kq = lane >> 3, n4 = lane & 7;
    f32x4 v[8];
#pragma unroll
    for (int i = 0; i < 8; ++i) { const int k = k0 + 2 * kq + (i & 1) + 16 * (i >> 1); v[i] = *(const f32x4*)(W + (size_t)k * N + n0 + 4 * n4); }
    if (kscale) {
#pragma unroll
        for (int i = 0; i < 8; ++i) { const int k = k0 + 2 * kq + (i & 1) + 16 * (i >> 1); v[i] = v[i] * kscale[k]; } }
#pragma unroll
    for (int p = 0; p < 4; ++p)
#pragma unroll
        for (int j = 0; j < 4; ++j) scr[(4 * n4 + j) * 36 + kq + 8 * p] = pk2(v[2 * p][j], v[2 * p + 1][j]);
    LDS_WAIT(); asm volatile("" ::: "memory");
#pragma unroll
    for (int r = 0; r < 4; ++r) { const int nl = kq + 8 * r; const u32x4 o = *(const LAS u32x4*)(scr + nl * 36 + 4 * n4);
        *(u32x4*)(WT + (size_t)(dst_row0 + nl) * ldk + k0 + 8 * n4) = o; }
    LDS_WAIT(); asm volatile("" ::: "memory");
}

__device__ __forceinline__ void tr_item8(const float* W, int N, int k0, int n0, unsigned char* WT, int ldk, int dst_row0, LAS unsigned* scr, int lane) {
    const int kq = lane >> 3, n4 = lane & 7;
    f32x4 v[8];
#pragma unroll
    for (int i = 0; i < 8; ++i) { const int k = k0 + 4 * kq + (i & 3) + 32 * (i >> 2); v[i] = *(const f32x4*)(W + (size_t)k * N + n0 + 4 * n4) * W8_SCALE; }
#pragma unroll
    for (int q = 0; q < 2; ++q)
#pragma unroll
        for (int j = 0; j < 4; ++j) scr[(4 * n4 + j) * 20 + kq + 8 * q] = pk4_fp8(v[4 * q][j], v[4 * q + 1][j], v[4 * q + 2][j], v[4 * q + 3][j]);
    LDS_WAIT(); asm volatile("" ::: "memory");
#pragma unroll
    for (int r = 0; r < 2; ++r) { const int nl = (lane >> 2) + 16 * r, c = lane & 3; const u32x4 o = *(const LAS u32x4*)(scr + nl * 20 + 4 * c);
        *(u32x4*)(WT + (size_t)(dst_row0 + nl) * ldk + k0 + 16 * c) = o; }
    LDS_WAIT(); asm volatile("" ::: "memory");
}

namespace wt {
constexpr int KD8 = MOE_FP8 ? 2 : 1;
constexpr int I_IN = 32 * 115, I_UQ = 8 * 48, I_UKV = 8 * 64, I_OUT = 32 * 64 / (OUT_FP8 ? 2 : 1), I_W1 = 32 * 32 / KD8, I_W2 = 16 * 64 / KD8;
constexpr int NITEMS = I_IN + I_UQ + I_UKV + I_OUT + 16 * (2 * I_W1 + I_W2);
struct TrD { const float* W; unsigned char* WT; const float* ks; int N, k0, n0, ldk, row0, f8; };
__device__ __forceinline__ void decode(const int l, unsigned char* wb, int it, TrD& d) {
    int r = it; d.ks = nullptr; d.f8 = 0;
    if (r < I_IN) { const int kb = r / 115, nb = r % 115; d.W = kparams()->in[I_WIN] + (size_t)l * 2048 * DIN; d.N = DIN; d.k0 = kb * 64; d.n0 = nb * 32; d.WT = wb + W_IN; d.ldk = 2048 * 2; d.row0 = nb * 32; return; } r -= I_IN;
    if (r < I_UQ) { const int kb = r / 48, nb = r % 48, n0 = nb * 32; d.W = kparams()->in[I_WUQ] + (size_t)l * 512 * 1536; d.N = 1536; d.k0 = kb * 64; d.n0 = n0; d.WT = wb + W_UQ; d.ldk = 512 * 2; d.row0 = (n0 / 192) * 256 + (n0 % 192); d.ks = kparams()->in[I_QNORM] + l * 512; return; } r -= I_UQ;
    if (r < I_UKV) { const int kb = r / 64, nb = r % 64; d.W = kparams()->in[I_WUKV] + (size_t)l * 512 * 2048; d.N = 2048; d.k0 = kb * 64; d.n0 = nb * 32; d.WT = wb + W_UKV; d.ldk = 512 * 2; d.row0 = nb * 32; d.ks = kparams()->in[I_KVNORM] + l * 512; return; } r -= I_UKV;
    if (r < I_OUT) { const int kb = r / 64, nb = r % 64; d.W = kparams()->in[I_WOUT] + (size_t)l * 2048 * 2048; d.N = 2048; d.k0 = kb * 64 * (OUT_FP8 ? 2 : 1); d.n0 = nb * 32; d.WT = wb + W_OUT; d.ldk = 2048 * (OUT_FP8 ? 1 : 2); d.row0 = nb * 32; d.f8 = OUT_FP8; return; } r -= I_OUT;
    const int e = r / (2 * I_W1 + I_W2); r -= e * (2 * I_W1 + I_W2); d.f8 = MOE_FP8;
    if (r < 2 * I_W1) { const int which = r / I_W1; r -= which * I_W1; const int kb = r / 32, nb = r % 32, n0 = nb * 32;
        d.W = kparams()->in[which ? I_MW3 : I_MW1] + ((size_t)l * NEXP + e) * 2048 * 1024; d.N = 1024; d.k0 = kb * 64 * KD8; d.n0 = n0;
        d.WT = wb + W_GU + (size_t)e * 2048 * 2048 * (MOE_FP8 ? 1 : 2); d.ldk = 2048 * (MOE_FP8 ? 1 : 2); d.row0 = (n0 >> 7) * 256 + which * 128 + (n0 & 127); return; }
    r -= 2 * I_W1;
    { const int kb = r / 64, nb = r % 64; d.W = kparams()->in[I_MW2] + ((size_t)l * NEXP + e) * 1024 * 2048; d.N = 2048; d.k0 = kb * 64 * KD8; d.n0 = nb * 32;
      d.WT = wb + W_2 + (size_t)e * 2048 * 1024 * (MOE_FP8 ? 1 : 2); d.ldk = 1024 * (MOE_FP8 ? 1 : 2); d.row0 = nb * 32; }
}
}
#if W_NTS
#define W_ST(v, p) __builtin_nontemporal_store(v, p)
#else
#define W_ST(v, p) (*(p) = (v))
#endif
#if W_NT
#define W_LD(p) __builtin_nontemporal_load(p)
#else
#define W_LD(p) (*(p))
#endif
#define TR_LOAD(D, V) do { if ((D).f8) { _Pragma("unroll") for (int i = 0; i < 16; ++i) { const int k = (D).k0 + 4 * kq + (i & 3) + 32 * (i >> 2); V[i] = W_LD((const f32x4*)((D).W + (size_t)k * (D).N + (D).n0 + 4 * n4)); } } \
        else { _Pragma("unroll") for (int i = 0; i < 8; ++i) { const int k = (D).k0 + 2 * kq + (i & 1) + 16 * (i >> 1); V[i] = W_LD((const f32x4*)((D).W + (size_t)k * (D).N + (D).n0 + 4 * n4)); } } } while (0)
#define TR_STORE(D, V) do { \
        if ((D).f8) { \
            _Pragma("unroll") for (int q = 0; q < 4; ++q) _Pragma("unroll") for (int j = 0; j < 4; ++j) \
                scr[(4 * n4 + j) * 36 + kq + 8 * q] = pk4_fp8(V[4 * q][j] * W8_SCALE, V[4 * q + 1][j] * W8_SCALE, V[4 * q + 2][j] * W8_SCALE, V[4 * q + 3][j] * W8_SCALE); \
            LDS_WAIT(); asm volatile("" ::: "memory"); \
            _Pragma("unroll") for (int r = 0; r < 4; ++r) { const int nl = kq + 8 * r; const u32x4 o = *(const LAS u32x4*)(scr + nl * 36 + 4 * n4); \
                W_ST(o, (u32x4*)((D).WT + (size_t)((D).row0 + nl) * (D).ldk + (D).k0 + 16 * n4)); } \
        } else { \
            if ((D).ks) { _Pragma("unroll") for (int i = 0; i < 8; ++i) { const int k = (D).k0 + 2 * kq + (i & 1) + 16 * (i >> 1); V[i] = V[i] * (D).ks[k]; } } \
            _Pragma("unroll") for (int p = 0; p < 4; ++p) _Pragma("unroll") for (int j = 0; j < 4; ++j) scr[(4 * n4 + j) * 36 + kq + 8 * p] = pk2(V[2 * p][j], V[2 * p + 1][j]); \
            LDS_WAIT(); asm volatile("" ::: "memory"); \
            _Pragma("unroll") for (int r = 0; r < 4; ++r) { const int nl = kq + 8 * r; const u32x4 o = *(const LAS u32x4*)(scr + nl * 36 + 4 * n4); \
                *(u32x4*)((D).WT + (size_t)((D).row0 + nl) * (D).ldk + ((D).k0 + 8 * n4) * 2) = o; } \
        } \
        LDS_WAIT(); asm volatile("" ::: "memory"); } while (0)
#define WF_DECL() wt::TrD wfd; f32x4 wfv[16]; bool wfp = false
#define WF_LOAD(l1, done) do { const int it_ = F.bid * 8 + F.wave + F.G * 8 * (done); wfp = it_ < wt::NITEMS; \
        if (wfp) { wt::decode((l1), F.ws + WS_W + (size_t)(l1) * WL_BYTES, it_, wfd); TR_LOAD(wfd, wfv); } } while (0)
#define WF_STORE(done) do { if (wfp) { TR_STORE(wfd, wfv); ++(done); } } while (0)
__device__ __forceinline__ void phase_weights(const Frame& F, const int l, const int frac_lo, const int frac_hi, const int nblk, const int brank, const bool with_small, const int done0 = 0) {
    unsigned char* wb = F.ws + WS_W + (size_t)l * WL_BYTES;
    if (l == 0 && with_small) {
        LAS float* sc = (LAS float*)F.lds;
        LAS float* red = (LAS float*)(F.lds + 5 * 2048 * 4);
        for (int i = F.tid; i < 5 * 2048; i += 512) { const int r = i >> 11, k = i & 2047; const float x = (r < 4) ? kparams()->in[I_C][r * 2048 + k] : kparams()->in[I_CCTX][k]; sc[i] = silu_f(x); }
        __syncthreads();
#if ADA_KSPLIT
        for (int it = F.bid; it < 768; it += F.G) {
            const int kh = it / 384, rem = it % 384, ll = rem / 192, cg = rem % 192; const float* W = kparams()->in[I_ADAW] + (size_t)ll * 2048 * 12288 + cg * 64 + F.lane;
            float a0 = 0.f, a1 = 0.f, a2 = 0.f, a3 = 0.f, a4 = 0.f; const int kb = kh * 1024 + F.wave * 128;
            for (int k0 = 0; k0 < 128; k0 += 32) { float w[32];
#pragma unroll
                for (int k = 0; k < 32; ++k) w[k] = NT_LD(W + (size_t)(kb + k0 + k) * 12288);
#pragma unroll
                for (int k = 0; k < 32; ++k) { const int kk = kb + k0 + k; a0 += sc[kk] * w[k]; a1 += sc[2048 + kk] * w[k]; a2 += sc[4096 + kk] * w[k]; a3 += sc[6144 + kk] * w[k]; a4 += sc[8192 + kk] * w[k]; } }
            LAS float* rw = red + F.wave * 320; rw[F.lane] = a0; rw[64 + F.lane] = a1; rw[128 + F.lane] = a2; rw[192 + F.lane] = a3; rw[256 + F.lane] = a4;
            __syncthreads();
            if (F.tid < 320) { float s = 0.f;
#pragma unroll
                for (int w = 0; w < 8; ++w) s += red[w * 320 + F.tid];
                const int r = F.tid >> 6, col = cg * 64 + (F.tid & 63);
                if (kh == 0) s += kparams()->in[I_ADAB][ll * 12288 + col];
                __hip_atomic_fetch_add((float*)(F.ws + WS_MOD) + (size_t)(ll * 5 + r) * 12288 + col, s, __ATOMIC_RELAXED, __HIP_MEMORY_SCOPE_AGENT); }
            __syncthreads();
        }
#else
        for (int it_ = F.bid; it_ < 2 * 192 * RP_ADA; it_ += F.G) { const int it = it_ % 384;
            const int ll = it / 192, cg = it % 192; const float* W = kparams()->in[I_ADAW] + (size_t)ll * 2048 * 12288 + cg * 64 + F.lane;
            float a0 = 0.f, a1 = 0.f, a2 = 0.f, a3 = 0.f, a4 = 0.f; const int kb = F.wave * 256;
            for (int k0 = 0; k0 < 256; k0 += 32) { float w[32];
#pragma unroll
                for (int k = 0; k < 32; ++k) w[k] = NT_LD(W + (size_t)(kb + k0 + k) * 12288);
#pragma unroll
                for (int k = 0; k < 32; ++k) { const int kk = kb + k0 + k; a0 += sc[kk] * w[k]; a1 += sc[2048 + kk] * w[k]; a2 += sc[4096 + kk] * w[k]; a3 += sc[6144 + kk] * w[k]; a4 += sc[8192 + kk] * w[k]; } }
            LAS float* rw = red + F.wave * 320; rw[F.lane] = a0; rw[64 + F.lane] = a1; rw[128 + F.lane] = a2; rw[192 + F.lane] = a3; rw[256 + F.lane] = a4;
            __syncthreads();
            if (F.tid < 320) { float s = 0.f;
#pragma unroll
                for (int w = 0; w < 8; ++w) s += red[w * 320 + F.tid];
                const int r = F.tid >> 6, col = cg * 64 + (F.tid & 63);
                ((float*)(F.ws + WS_MOD))[(size_t)(ll * 5 + r) * 12288 + col] = s + kparams()->in[I_ADAB][ll * 12288 + col]; }
            __syncthreads();
        }
#endif
        if (F.bid == F.G - 1) { for (int i = F.tid; i < 64 * 16; i += 512) { const int pos = i >> 4, j = i & 15;
                const float inv = powf(10000.0f, -(float)j / 16.0f); const float ang = (float)pos * inv; float sn, cs; sincosf(ang, &sn, &cs);
                ((f32x2*)(F.ws + WS_ROPE))[i] = (f32x2){cs, sn}; } }
        __syncthreads();
    }
    LAS unsigned* scr = (LAS unsigned*)(F.lds + F.wave * 4608);
    const int gw = brank * 8 + F.wave, NGW = nblk * 8;
    const int kq = F.lane >> 3, n4 = F.lane & 7;
    { wt::TrD dA, dB; f32x4 vA[16], vB[16]; const int IT_LO = (int)((long)wt::NITEMS * frac_lo / 16), IT_HI = (int)((long)wt::NITEMS * frac_hi / 16); int it = IT_LO + gw + NGW * done0;
      if (it < IT_HI) { wt::decode(l, wb, it, dA); TR_LOAD(dA, vA); }
      while (it < IT_HI) {
          const int it1 = it + NGW; if (it1 < IT_HI) { wt::decode(l, wb, it1, dB); TR_LOAD(dB, vB); }
          TR_STORE(dA, vA);
          if (it1 >= IT_HI) break;
          const int it2 = it1 + NGW; if (it2 < IT_HI) { wt::decode(l, wb, it2, dA); TR_LOAD(dA, vA); }
          TR_STORE(dB, vB);
          it = it2; } }
    if (with_small) { const float* sw = kparams()->in[I_SGUW] + (size_t)l * 4 * 128 * 128; unsigned* dst = (unsigned*)(wb + W_SGU);
      for (int i = F.bid * 512 + F.tid; i < 4 * 128 * 128 / 2; i += F.G * 512) dst[i] = pk2(sw[2 * i], sw[2 * i + 1]); }
}

__device__ __forceinline__ void moe_table(const Frame& F, const int l, LAS int* tstart) {
    if (F.tid < 64) { unsigned* gcnt = F.ctl + CW_CNT + l * 64;
        const int c = (F.lane < 16) ? (int)__hip_atomic_load(gcnt + F.lane, __ATOMIC_RELAXED, __HIP_MEMORY_SCOPE_AGENT) : 0; const int t = (c + 255) >> 8; int incl = t;
#pragma unroll
        for (int k = 1; k < 16; k <<= 1) { const int v = __shfl_up(incl, k); if (F.lane >= k) incl += v; }
        if (F.lane < 16) { tstart[F.lane] = incl - t; tstart[32 + F.lane] = c; } if (F.lane == 15) tstart[16] = incl; }
    __syncthreads();
}
template <int MODE>
__device__ __forceinline__ void phase_rows(const Frame& F, const int l) {
    LAS float* gs = (LAS float*)F.lds;
    LAS float* sh = gs + 5 * 2048;
    LAS float* g2 = sh + 5 * 2048;
    const float* modl = (const float*)(F.ws + WS_MOD) + (size_t)(MODE == 2 ? 0 : l) * 5 * 12288;
    const float* modp = (const float*)(F.ws + WS_MOD) + (size_t)(MODE == 2 ? 1 : (l - 1)) * 5 * 12288;
    for (int i = F.tid; i < 5 * 2048; i += 512) { const int r = i >> 11, k = i & 2047;
        if (MODE != 2) { gs[i] = kparams()->in[I_N1G][l * 2048 + k] * (1.f + modl[r * 12288 + 2048 + k]); sh[i] = modl[r * 12288 + k]; }
        if (MODE != 0) g2[i] = modp[r * 12288 + 5 * 2048 + k]; }
    __syncthreads();
    const int gw = F.bid * 8 + F.wave, NGW = F.G * 8; const int nrows = (MODE == 2) ? NLAT : NTOK;
    const bf16_t* X1 = (const bf16_t*)(F.ws + WS_X1); bf16_t* X2 = (bf16_t*)(F.ws + WS_X2); bf16_t* H = (bf16_t*)(F.ws + WS_H);
    const bf16_t* Y = (const bf16_t*)(F.ws + WS_R + R_Y); const int* toks = (const int*)(F.ws + WS_TOKS); const float* cw = (const float*)(F.ws + WS_CW);
#if MOE_GATHER
    LAS int* tstart = (LAS int*)(F.scr + 8192); const int* toke = (const int*)(F.ws + WS_TOKE); const int* toki = (const int*)(F.ws + WS_TOKI);
    if (MODE != 0) moe_table(F, MODE == 2 ? DEPTH - 1 : l - 1, tstart);
#define SLOT_OF(row, k) (tstart[toke[(row) * 2 + (k)]] * 256 + toki[(row) * 2 + (k)])
#else
#define SLOT_OF(row, k) toks[(row) * 2 + (k)]
#endif
    struct RowRaw { f32x4 xf[8]; u32x2 xb[8], ya[8], yb[8]; float c0, c1; };
#define ROW_LOAD(R, row) do { \
        if (MODE == 0) { const float* src = ((row) < NLAT) ? kparams()->in[I_X] + (size_t)(row) * DM : kparams()->in[I_CTX] + (size_t)((row) - NLAT) * DM; \
            _Pragma("unroll") for (int i = 0; i < 8; ++i) R.xf[i] = NT_LD((const f32x4*)(src + 256 * i + 4 * F.lane)); } \
        else { const bf16_t* src = X1 + (size_t)(row) * DM; const int s0 = SLOT_OF(row, 0), s1 = SLOT_OF(row, 1); R.c0 = cw[(row) * 2]; R.c1 = cw[(row) * 2 + 1]; \
            const bf16_t* y0 = Y + (size_t)s0 * DM; const bf16_t* y1 = Y + (size_t)s1 * DM; \
            _Pragma("unroll") for (int i = 0; i < 8; ++i) { R.xb[i] = NT_LD((const u32x2*)(src + 256 * i + 4 * F.lane)); R.ya[i] = NT_LD((const u32x2*)(y0 + 256 * i + 4 * F.lane)); R.yb[i] = NT_LD((const u32x2*)(y1 + 256 * i + 4 * F.lane)); } } } while (0)
#define ROW_PROC(R, row) do { const int mr = mod_row_of(row); f32x4 v[8]; \
        if (MODE == 0) { _Pragma("unroll") for (int i = 0; i < 8; ++i) v[i] = R.xf[i]; } \
        else { \
            _Pragma("unroll") for (int i = 0; i < 8; ++i) { const u32x2 xw = R.xb[i], a = R.ya[i], b = R.yb[i]; \
                const f32x4 g = *(const LAS f32x4*)(g2 + mr * 2048 + 256 * i + 4 * F.lane); \
                const f32x4 x = (f32x4){bflo(xw.x), bfhi(xw.x), bflo(xw.y), bfhi(xw.y)}; \
                const f32x4 ya = (f32x4){bflo(a.x), bfhi(a.x), bflo(a.y), bfhi(a.y)}, yb = (f32x4){bflo(b.x), bfhi(b.x), bflo(b.y), bfhi(b.y)}; \
                v[i] = x + g * (ya * R.c0 + yb * R.c1); } \
            if (MODE == 2) { float* dst = kparams()->out + (size_t)(row) * DM; \
                _Pragma("unroll") for (int i = 0; i < 8; ++i) NT_ST(v[i], (f32x4*)(dst + 256 * i + 4 * F.lane)); \
            } else { bf16_t* dst = X2 + (size_t)(row) * DM; \
                _Pragma("unroll") for (int i = 0; i < 8; ++i) { u32x2 w; w.x = cvt_pk_bf16(v[i][0], v[i][1]); w.y = cvt_pk_bf16(v[i][2], v[i][3]); *(u32x2*)(dst + 256 * i + 4 * F.lane) = w; \
                    v[i] = (f32x4){bflo(w.x), bfhi(w.x), bflo(w.y), bfhi(w.y)}; } } \
        } \
        if (MODE != 2) { float s = 0.f; \
            _Pragma("unroll") for (int i = 0; i < 8; ++i) s += (v[i][0] * v[i][0] + v[i][1] * v[i][1]) + (v[i][2] * v[i][2] + v[i][3] * v[i][3]); \
            const float r = 1.0f / sqrtf(wave_sum(s) * (1.0f / DM) + EPS); \
            bf16_t* hp = H + (size_t)(row) * DM; \
            _Pragma("unroll") for (int i = 0; i < 8; ++i) { const f32x4 g = *(const LAS f32x4*)(gs + mr * 2048 + 256 * i + 4 * F.lane), b = *(const LAS f32x4*)(sh + mr * 2048 + 256 * i + 4 * F.lane); \
                const f32x4 o = v[i] * r * g + b; u32x2 w; w.x = cvt_pk_bf16(o[0], o[1]); w.y = cvt_pk_bf16(o[2], o[3]); *(u32x2*)(hp + 256 * i + 4 * F.lane) = w; } } } while (0)
    { RowRaw A, B; int row = gw;
      if (row < nrows) ROW_LOAD(A, row);
      while (row < nrows) {
          const int r1 = row + NGW; if (r1 < nrows) ROW_LOAD(B, r1);
          ROW_PROC(A, row);
          if (r1 >= nrows) break;
          const int r2 = r1 + NGW; if (r2 < nrows) ROW_LOAD(A, r2);
          ROW_PROC(B, r1);
          row = r2; } }
#undef ROW_LOAD
#undef SLOT_OF
#undef ROW_PROC
}


namespace attn {
constexpr int KVBLK = 64, QBLK = 32;
constexpr float SCALE = 0.07216878364870322f;
constexpr float THR = 8.f;
constexpr int SHM_V = KVBLK * VD * 2, SHM_KN = KVBLK * NOPE * 2, SHM_KP = KVBLK * ROPE * 2;
constexpr int NBUF = ATTN_NBUF;
constexpr int OFF_V = 0, OFF_KN = NBUF * SHM_V, OFF_KP = OFF_KN + NBUF * SHM_KN, OFF_WS = OFF_KP + NBUF * SHM_KP, OFF_QP = OFF_WS + 8 * 64 * 4, LDS_ATTN = OFF_QP + 8 * 4 * 64 * 16;
static_assert(LDS_ATTN <= MISC_OFF, "attention LDS");
#define KSWZ(row, colB) ((row) * 256 + ((colB) ^ (((row) & 7) << 4)))
#define PSWZ(row, colB) ((row) * 128 + ((colB) ^ (((row) & 7) << 4)))
#define SBAR() __builtin_amdgcn_sched_barrier(0)
__device__ __forceinline__ int crow(int r, int hi) { return (r & 3) + 8 * (r >> 2) + 4 * hi; }
__device__ __forceinline__ unsigned cvtpk(float lo, float hi) { unsigned r; asm("v_cvt_pk_bf16_f32 %0, %1, %2" : "=v"(r) : "v"(lo), "v"(hi)); return r; }

__device__ __forceinline__ void partialSM(f32x16& p0, f32x16& p1, float& m_reg, float& mn, float& alpha) {
  constexpr float C = SCALE * 1.4426950408889634f;
  float pmax = p0[0];
#pragma unroll
  for (int r = 1; r < 16; ++r) pmax = fmaxf(pmax, p0[r]);
#pragma unroll
  for (int r = 0; r < 16; ++r) pmax = fmaxf(pmax, p1[r]);
  { auto rr = __builtin_amdgcn_permlane32_swap(__float_as_uint(pmax), __float_as_uint(pmax), false, false);
    pmax = fmaxf(__uint_as_float(rr[0]), __uint_as_float(rr[1])); }
  if (__builtin_expect(__all(pmax - m_reg <= THR / SCALE), 1)) { mn = m_reg; alpha = 1.f; }
  else { mn = fmaxf(m_reg, pmax); alpha = __builtin_amdgcn_exp2f((m_reg - mn) * C); m_reg = mn; }
  float mnC = -mn * C;
#pragma unroll
  for (int r = 0; r < 16; ++r) p0[r] = fmaf(p0[r], C, mnC);
#pragma unroll
  for (int r = 0; r < 16; ++r) p1[r] = fmaf(p1[r], C, mnC);
#pragma unroll
  for (int r = 0; r < 16; ++r) p0[r] = __builtin_amdgcn_exp2f(p0[r]);
}
__device__ __forceinline__ void finishSM(f32x16& p0, f32x16& p1, float alpha, float& l_reg, bf16x8& pa0, bf16x8& pa1, bf16x8& pa2, bf16x8& pa3) {
#pragma unroll
  for (int r = 0; r < 16; ++r) p1[r] = __builtin_amdgcn_exp2f(p1[r]);
  float ps = 0;
#pragma unroll
  for (int r = 0; r < 16; ++r) ps += p0[r];
#pragma unroll
  for (int r = 0; r < 16; ++r) ps += p1[r];
  { auto rr = __builtin_amdgcn_permlane32_swap(__float_as_uint(ps), __float_as_uint(ps), false, false);
    ps = __uint_as_float(rr[0]) + __uint_as_float(rr[1]); }
  l_reg = l_reg * alpha + ps;
#define PK4(P, BASE, OUT) do { unsigned a0 = cvtpk(P[BASE + 0], P[BASE + 1]), a1 = cvtpk(P[BASE + 2], P[BASE + 3]);   \
    unsigned b0 = cvtpk(P[BASE + 4], P[BASE + 5]), b1 = cvtpk(P[BASE + 6], P[BASE + 7]);                              \
    auto r0 = __builtin_amdgcn_permlane32_swap(a0, b0, false, false); auto r1 = __builtin_amdgcn_permlane32_swap(a1, b1, false, false); \
    u32x4 w = {r0[0], r1[0], r0[1], r1[1]}; OUT = *reinterpret_cast<bf16x8*>(&w); } while (0)
  PK4(p0, 0, pa0); PK4(p0, 8, pa1); PK4(p1, 0, pa2); PK4(p1, 8, pa3);
#undef PK4
}
__device__ __forceinline__ void qkt(f32x16& p0, f32x16& p1, const char* Kn, const char* Kp, const bf16x8* qr, const char* qp, int r32, int hi) {
  p0 = f32x16{}; p1 = f32x16{};
#pragma unroll
  for (int d0 = 0; d0 < 8; ++d0) { const int cb = (d0 * 16 + hi * 8) * 2;
    bf16x8 b0 = *reinterpret_cast<const bf16x8*>(Kn + KSWZ(r32, cb));
    bf16x8 b1 = *reinterpret_cast<const bf16x8*>(Kn + KSWZ(32 + r32, cb));
    p0 = __builtin_amdgcn_mfma_f32_32x32x16_bf16(b0, qr[d0], p0, 0, 0, 0);
    p1 = __builtin_amdgcn_mfma_f32_32x32x16_bf16(b1, qr[d0], p1, 0, 0, 0); }
#pragma unroll
  for (int d0 = 0; d0 < 4; ++d0) { const int cb = (d0 * 16 + hi * 8) * 2;
    bf16x8 b0 = *reinterpret_cast<const bf16x8*>(Kp + PSWZ(r32, cb));
    bf16x8 b1 = *reinterpret_cast<const bf16x8*>(Kp + PSWZ(32 + r32, cb));
    const bf16x8 qf = *reinterpret_cast<const bf16x8*>(qp + d0 * 1024);
    p0 = __builtin_amdgcn_mfma_f32_32x32x16_bf16(b0, qf, p0, 0, 0, 0);
    p1 = __builtin_amdgcn_mfma_f32_32x32x16_bf16(b1, qf, p1, 0, 0, 0); }
}
__device__ __forceinline__ int v_st(int k, int c) { const int kk = (k & ~0xC) | ((k & 4) << 1) | ((k & 8) >> 1); return ((kk >> 3) * 4 + (c >> 5)) * 512 + ((kk & 7) * 32 + (c & 31)) * 2; }
__device__ __forceinline__ int v_rd_base(int lane) { return ((lane & 3) << 3) | (((lane >> 2) & 3) << 6) | (((lane >> 4) & 1) << 5) | (((lane >> 5) & 1) << 8); }
constexpr int v_rd_off(int d0, int ks, int half) { return d0 * 512 + ks * 4096 + half * 2048; }
template <int OFF> __device__ __forceinline__ s16x4 tr_read(int vb) {
  s16x4 r; asm volatile("ds_read_b64_tr_b16 %0, %1 offset:%2" : "=&v"(r) : "v"(vb), "i"(OFF) : "memory"); return r;
}
template <int D0> __device__ __forceinline__ void pv_one(f32x16& od, int vb, bf16x8 pa0, bf16x8 pa1, bf16x8 pa2, bf16x8 pa3) {
  const s16x4 l0 = tr_read<v_rd_off(D0, 0, 0)>(vb), h0 = tr_read<v_rd_off(D0, 0, 1)>(vb), l1 = tr_read<v_rd_off(D0, 1, 0)>(vb), h1 = tr_read<v_rd_off(D0, 1, 1)>(vb);
  const s16x4 l2 = tr_read<v_rd_off(D0, 2, 0)>(vb), h2 = tr_read<v_rd_off(D0, 2, 1)>(vb), l3 = tr_read<v_rd_off(D0, 3, 0)>(vb), h3 = tr_read<v_rd_off(D0, 3, 1)>(vb);
  asm volatile("s_waitcnt lgkmcnt(0)" ::: "memory"); SBAR();
#define PK(L, H) (bf16x8){L[0], L[1], L[2], L[3], H[0], H[1], H[2], H[3]}
  od = __builtin_amdgcn_mfma_f32_32x32x16_bf16(pa0, PK(l0, h0), od, 0, 0, 0);
  od = __builtin_amdgcn_mfma_f32_32x32x16_bf16(pa1, PK(l1, h1), od, 0, 0, 0);
  od = __builtin_amdgcn_mfma_f32_32x32x16_bf16(pa2, PK(l2, h2), od, 0, 0, 0);
  od = __builtin_amdgcn_mfma_f32_32x32x16_bf16(pa3, PK(l3, h3), od, 0, 0, 0);
#undef PK
}
__device__ __forceinline__ void pv_d0(f32x16* o, int vb, bf16x8 pa0, bf16x8 pa1, bf16x8 pa2, bf16x8 pa3) {
  pv_one<0>(o[0], vb, pa0, pa1, pa2, pa3); pv_one<1>(o[1], vb, pa0, pa1, pa2, pa3); pv_one<2>(o[2], vb, pa0, pa1, pa2, pa3); pv_one<3>(o[3], vb, pa0, pa1, pa2, pa3);
}

__device__ __forceinline__ void pv_sm(f32x16* o, int vb, bf16x8 pa0, bf16x8 pa1, bf16x8 pa2, bf16x8 pa3, f32x16& p0, f32x16& p1, float& m_reg, float& mn, float& alpha) {
  constexpr float C = SCALE * 1.4426950408889634f;
#define PV_READS(D0) const s16x4 l0 = tr_read<v_rd_off(D0, 0, 0)>(vb), h0 = tr_read<v_rd_off(D0, 0, 1)>(vb), l1 = tr_read<v_rd_off(D0, 1, 0)>(vb), h1 = tr_read<v_rd_off(D0, 1, 1)>(vb); \
  const s16x4 l2 = tr_read<v_rd_off(D0, 2, 0)>(vb), h2 = tr_read<v_rd_off(D0, 2, 1)>(vb), l3 = tr_read<v_rd_off(D0, 3, 0)>(vb), h3 = tr_read<v_rd_off(D0, 3, 1)>(vb); \
  PV_WAIT_EARLY()
#if PV_LATE_WAIT
#define PV_WAIT_EARLY() SBAR();
#define PV_WAIT_LATE() SBAR(); asm volatile("s_waitcnt lgkmcnt(0)" ::: "memory"); SBAR();
#else
#define PV_WAIT_EARLY() asm volatile("s_waitcnt lgkmcnt(0)" ::: "memory"); SBAR();
#define PV_WAIT_LATE()
#endif
#define PK(L, H) (bf16x8){L[0], L[1], L[2], L[3], H[0], H[1], H[2], H[3]}
#define PV_MMA(D0) PV_WAIT_LATE() o[D0] = __builtin_amdgcn_mfma_f32_32x32x16_bf16(pa0, PK(l0, h0), o[D0], 0, 0, 0); o[D0] = __builtin_amdgcn_mfma_f32_32x32x16_bf16(pa1, PK(l1, h1), o[D0], 0, 0, 0); \
  o[D0] = __builtin_amdgcn_mfma_f32_32x32x16_bf16(pa2, PK(l2, h2), o[D0], 0, 0, 0); o[D0] = __builtin_amdgcn_mfma_f32_32x32x16_bf16(pa3, PK(l3, h3), o[D0], 0, 0, 0);
  float pmax;
  { PV_READS(0)
    pmax = p0[0];
#pragma unroll
    for (int r = 1; r < 16; ++r) pmax = fmaxf(pmax, p0[r]);
    PV_MMA(0) }
  float mnC;
  { PV_READS(1)
#pragma unroll
    for (int r = 0; r < 16; ++r) pmax = fmaxf(pmax, p1[r]);
    { auto rr = __builtin_amdgcn_permlane32_swap(__float_as_uint(pmax), __float_as_uint(pmax), false, false); pmax = fmaxf(__uint_as_float(rr[0]), __uint_as_float(rr[1])); }
    if (__builtin_expect(__all(pmax - m_reg <= THR / SCALE), 1)) { mn = m_reg; alpha = 1.f; }
    else { mn = fmaxf(m_reg, pmax); alpha = __builtin_amdgcn_exp2f((m_reg - mn) * C); m_reg = mn; }
    mnC = -mn * C;
    PV_MMA(1) }
  { PV_READS(2)
#pragma unroll
    for (int r = 0; r < 16; ++r) p0[r] = fmaf(p0[r], C, mnC);
#pragma unroll
    for (int r = 0; r < 16; ++r) p1[r] = fmaf(p1[r], C, mnC);
    PV_MMA(2) }
  { PV_READS(3)
#pragma unroll
    for (int r = 0; r < 16; ++r) p0[r] = __builtin_amdgcn_exp2f(p0[r]);
    PV_MMA(3) }
#undef PV_READS
#undef PV_WAIT_EARLY
#undef PV_WAIT_LATE
#undef PV_MMA
#undef PK
}

__device__ __forceinline__ void attn_body(const int tid, const bf16_t* __restrict__ Qb, const bf16_t* __restrict__ Kh, const bf16_t* __restrict__ Vh, MixT* __restrict__ Ob,
                                          const int rowA, const int nA, const int rowB, const int NT, char* lds) {
  const int wid = __builtin_amdgcn_readfirstlane(tid >> 6), lane = tid & 63, r32 = lane & 31, hi = lane >> 5;
  char* V_lds = lds + OFF_V; char* Kn_lds = lds + OFF_KN; char* Kp_lds = lds + OFF_KP;
  float* ws = (float*)(lds + OFF_WS) + wid * 64; float* li_l = ws; float* al_l = ws + 32;
  float m_reg = -1e30f, l_reg = 0; f32x16 o[4] = {}; bf16x8 qr[8];
  const bf16_t* Qw = Qb + (long)(wid * QBLK + r32) * QLD + hi * 8;
#pragma unroll
  for (int d0 = 0; d0 < 8; ++d0) qr[d0] = *reinterpret_cast<const bf16x8*>(Qw + d0 * 16);
  char* qp = lds + OFF_QP + wid * 4096 + lane * 16;
#pragma unroll
  for (int d0 = 0; d0 < 4; ++d0) *reinterpret_cast<bf16x8*>(qp + d0 * 1024) = *reinterpret_cast<const bf16x8*>(Qw + (8 + d0) * 16);
  const int sr = tid >> 4, sc = (tid & 15) * 8, vst0 = v_st(sr, sc), vst1 = v_st(32 + sr, sc);
  const int kr = tid >> 3, kc = (tid & 7) * 8;
  const int vb0 = (int)(uintptr_t)V_lds + v_rd_base(lane);
  bf16x8 vs0, vs1, ks0, ks1, kp0;
#define TROW(j) ((j) < nA ? rowA + 64 * (j) : rowB + 64 * ((j) - nA))
#define SLOAD(j) do { const long _t0 = TROW(j); \
    vs0 = *reinterpret_cast<const bf16x8*>(&Vh[(_t0 + sr) * VLD + sc]); vs1 = *reinterpret_cast<const bf16x8*>(&Vh[(_t0 + 32 + sr) * VLD + sc]); \
    ks0 = *reinterpret_cast<const bf16x8*>(&Kh[(_t0 + sr) * QLD + sc]); ks1 = *reinterpret_cast<const bf16x8*>(&Kh[(_t0 + 32 + sr) * QLD + sc]); \
    kp0 = *reinterpret_cast<const bf16x8*>(&Kh[(_t0 + kr) * QLD + NOPE + kc]); } while (0)
#define SWRITE(b) do { *(bf16x8*)(V_lds + (b) * SHM_V + vst0) = vs0; *(bf16x8*)(V_lds + (b) * SHM_V + vst1) = vs1; \
    *(bf16x8*)(Kn_lds + (b) * SHM_KN + KSWZ(sr, sc * 2)) = ks0; *(bf16x8*)(Kn_lds + (b) * SHM_KN + KSWZ(32 + sr, sc * 2)) = ks1; \
    *(bf16x8*)(Kp_lds + (b) * SHM_KP + PSWZ(kr, kc * 2)) = kp0; } while (0)
#define SWAIT() asm volatile("s_waitcnt vmcnt(0)" ::: "memory")
#define RESC(a) do { if (__any((a) < 1.f)) { if (hi == 0) al_l[r32] = (a); asm volatile("s_waitcnt lgkmcnt(0)" ::: "memory"); \
    _Pragma("unroll") for (int d = 0; d < 4; ++d) _Pragma("unroll") for (int r = 0; r < 16; ++r) o[d][r] *= al_l[crow(r, hi)]; } } while (0)
  f32x16 pA0, pA1, pB0, pB1; float mnA, mnB, alA, alB; bf16x8 pa0, pa1, pa2, pa3;
#if ATTN_NBUF == 3
#define SWRITE_R(ob) do { *(bf16x8*)(V_lds + (ob) + vst0) = vs0; *(bf16x8*)(V_lds + (ob) + vst1) = vs1; \
    *(bf16x8*)(Kn_lds + (ob) + KSWZ(sr, sc * 2)) = ks0; *(bf16x8*)(Kn_lds + (ob) + KSWZ(32 + sr, sc * 2)) = ks1; \
    *(bf16x8*)(Kp_lds + ((ob) >> 1) + PSWZ(kr, kc * 2)) = kp0; } while (0)
#define ROT() do { ov = oq; oq = ow; ow = (ow == 2 * (int)SHM_V) ? 0 : ow + (int)SHM_V; } while (0)
  static_assert(SHM_V == SHM_KN && SHM_KP * 2 == SHM_V, "ring offsets");
  SLOAD(0); SWAIT(); SWRITE_R(0); SLOAD(1); __syncthreads();
  qkt(pA0, pA1, Kn_lds, Kp_lds, qr, qp, r32, hi); partialSM(pA0, pA1, m_reg, mnA, alA);
  SWAIT(); SWRITE_R((int)SHM_V); SLOAD(2); __syncthreads();
  int oq = (int)SHM_V, ov = 0, ow = 2 * (int)SHM_V;
  for (int j = 1; j + 1 < NT; j += 2) {
    SBAR(); qkt(pB0, pB1, Kn_lds + oq, Kp_lds + (oq >> 1), qr, qp, r32, hi);
    finishSM(pA0, pA1, alA, l_reg, pa0, pa1, pa2, pa3); SBAR();
    pv_sm(o, vb0 + ov, pa0, pa1, pa2, pa3, pB0, pB1, m_reg, mnB, alB);
    SWAIT(); SWRITE_R(ow); SLOAD(j + 2); SBAR();
    RESC(alB); __syncthreads(); ROT();
    SBAR(); qkt(pA0, pA1, Kn_lds + oq, Kp_lds + (oq >> 1), qr, qp, r32, hi);
    finishSM(pB0, pB1, alB, l_reg, pa0, pa1, pa2, pa3); SBAR();
    pv_sm(o, vb0 + ov, pa0, pa1, pa2, pa3, pA0, pA1, m_reg, mnA, alA);
    SWAIT(); SWRITE_R(ow); if (j + 3 < NT) SLOAD(j + 3); SBAR();
    RESC(alA); __syncthreads(); ROT();
  }
  SBAR(); qkt(pB0, pB1, Kn_lds + oq, Kp_lds + (oq >> 1), qr, qp, r32, hi);
  finishSM(pA0, pA1, alA, l_reg, pa0, pa1, pa2, pa3); SBAR();
  pv_sm(o, vb0 + ov, pa0, pa1, pa2, pa3, pB0, pB1, m_reg, mnB, alB);
  RESC(alB);
  finishSM(pB0, pB1, alB, l_reg, pa0, pa1, pa2, pa3); SBAR();
  pv_d0(o, vb0 + oq, pa0, pa1, pa2, pa3);
#undef SWRITE_R
#undef ROT
#else
  SLOAD(0); SWAIT(); SWRITE(0); __syncthreads();
  qkt(pA0, pA1, Kn_lds, Kp_lds, qr, qp, r32, hi); partialSM(pA0, pA1, m_reg, mnA, alA);
  SLOAD(1);
  SWAIT(); SWRITE(1); __syncthreads();
  for (int j = 1; j + 1 < NT; j += 2) {
    SBAR(); qkt(pB0, pB1, Kn_lds + SHM_KN, Kp_lds + SHM_KP, qr, qp, r32, hi);
    finishSM(pA0, pA1, alA, l_reg, pa0, pa1, pa2, pa3); SBAR();
    SLOAD(j + 1); SBAR();
    pv_sm(o, vb0, pa0, pa1, pa2, pa3, pB0, pB1, m_reg, mnB, alB);
    __syncthreads(); SWAIT(); SWRITE(0);
    RESC(alB); __syncthreads();
    SBAR(); qkt(pA0, pA1, Kn_lds, Kp_lds, qr, qp, r32, hi);
    finishSM(pB0, pB1, alB, l_reg, pa0, pa1, pa2, pa3); SBAR();
    SLOAD(j + 2); SBAR();
    pv_sm(o, vb0 + (int)SHM_V, pa0, pa1, pa2, pa3, pA0, pA1, m_reg, mnA, alA);
    __syncthreads(); SWAIT(); SWRITE(1);
    RESC(alA); __syncthreads();
  }
  SBAR(); qkt(pB0, pB1, Kn_lds + SHM_KN, Kp_lds + SHM_KP, qr, qp, r32, hi);
  finishSM(pA0, pA1, alA, l_reg, pa0, pa1, pa2, pa3); SBAR();
  pv_sm(o, vb0, pa0, pa1, pa2, pa3, pB0, pB1, m_reg, mnB, alB);
  __syncthreads(); RESC(alB);
  finishSM(pB0, pB1, alB, l_reg, pa0, pa1, pa2, pa3); SBAR();
  pv_d0(o, vb0 + (int)SHM_V, pa0, pa1, pa2, pa3);
#endif
  if (hi == 0) li_l[r32] = l_reg; asm volatile("s_waitcnt lgkmcnt(0)" ::: "memory");
  float rli[16];
#pragma unroll
  for (int r = 0; r < 16; ++r) rli[r] = __builtin_amdgcn_rcpf(li_l[crow(r, hi)]);
  { int t2 = tid; asm volatile("" : "+v"(t2));
    const int w2 = __builtin_amdgcn_readfirstlane(t2 >> 6), c2 = t2 & 31, h2 = (t2 >> 5) & 1;
    MixT* Ow = Ob + (long)(w2 * QBLK) * DM + c2;
#pragma unroll
    for (int r = 0; r < 16; ++r) { const int orow = crow(r, h2);
#pragma unroll
      for (int d0 = 0; d0 < 4; d0 += 2) {
#if OUT_FP8
        const unsigned w = pk2_fp8(o[d0][r] * rli[r], o[d0 + 1][r] * rli[r]);
        Ow[(long)orow * DM + d0 * 32] = (unsigned char)(w & 0xFF); Ow[(long)orow * DM + d0 * 32 + 32] = (unsigned char)(w >> 8);
#else
Ow[(long)orow * DM + d0 * 32] = (bf16_t)f2bf(o[d0][r] * rli[r]); Ow[(long)orow * DM + d0 * 32 + 32] = (bf16_t)f2bf(o[d0 + 1][r] * rli[r]);
#endif
      } } }
  __syncthreads();
#undef TROW
#undef SLOAD
#undef SWRITE
#undef SWAIT
#undef RESC
}
#undef KSWZ
#undef PSWZ
#undef SBAR
}

template <int KS>
__device__ __forceinline__ f32x16 mma32(const LAS bf16_t* A, int lda, const LAS bf16_t* Bt, int ldb, f32x16 acc, int lane) {
    const int r = lane & 31, h = lane >> 5;
#pragma unroll
    for (int ks = 0; ks < KS; ++ks) {
        const bf16x8 a = *(const LAS bf16x8*)(A + r * lda + ks * 16 + 8 * h);
        const bf16x8 b = *(const LAS bf16x8*)(Bt + r * ldb + ks * 16 + 8 * h);
        acc = __builtin_amdgcn_mfma_f32_32x32x16_bf16(a, b, acc, 0, 0, 0); }
    return acc;
}
__device__ __forceinline__ int crow32(int v, int h) { return (v & 3) + 8 * (v >> 2) + 4 * h; }

struct UnitQ { int a, b; };
__device__ __forceinline__ void q_first(const Frame& F, unsigned* ctr, UnitQ& q) { q.a = 0; q.b = 0;
    if (F.tid == 0) { q.a = (int)__hip_atomic_fetch_add(ctr, 1u, __ATOMIC_RELAXED, __HIP_MEMORY_SCOPE_AGENT); q.b = (int)__hip_atomic_fetch_add(ctr, 1u, __ATOMIC_RELAXED, __HIP_MEMORY_SCOPE_AGENT); } }
__device__ __forceinline__ void q_next(const Frame& F, unsigned* ctr, UnitQ& q, int& cur, int& nxt) {
    lds_barrier();
    if (F.tid == 0) { F.MISC[16] = (unsigned)q.a; F.MISC[17] = (unsigned)q.b; q.a = q.b; q.b = (int)__hip_atomic_fetch_add(ctr, 1u, __ATOMIC_RELAXED, __HIP_MEMORY_SCOPE_AGENT); }
    lds_barrier();
    cur = (int)F.MISC[16]; nxt = (int)F.MISC[17];
}

constexpr int SGU_LD = 136;
__device__ __forceinline__ void sgu_unit(const Frame& F, const int l, const int un) {
    LAS bf16_t* Wl = (LAS bf16_t*)F.lds;
    LAS bf16_t* Vt = Wl + 128 * SGU_LD;
    const bf16_t* Z = (const bf16_t*)(F.ws + WS_R + R_Z); MixT* MIX = (MixT*)(F.ws + WS_R + R_MIX);
    const bf16_t* Wg = (const bf16_t*)(F.ws + WS_W + (size_t)l * WL_BYTES + W_SGU);
    const float* vgain = kparams()->in[I_SGUNORM] + l * 512; const float* bs = kparams()->in[I_SGUB] + l * 512;
    const int ch = un >> 2, g = un & 3; const int row0 = (ch < 128) ? ch * 128 : NLAT + (ch - 128) * 128;
    for (int i = F.tid; i < 2048; i += 512) { const int t = i >> 4, c = i & 15; *(LAS u32x4*)(Wl + t * SGU_LD + c * 8) = *(const u32x4*)(Wg + (size_t)g * 16384 + t * 128 + c * 8); }
    { const int s = F.tid >> 2, q = F.tid & 3; const bf16_t* zp = Z + (size_t)(row0 + s) * DINP + ZC_ZV + g * 128 + q * 32;
      float x[32]; float ssq = 0.f;
#pragma unroll
      for (int c = 0; c < 4; ++c) { const u32x4 w = *(const u32x4*)(zp + c * 8);
          x[c * 8 + 0] = gelu_tanh_f(bflo(w.x)); x[c * 8 + 1] = gelu_tanh_f(bfhi(w.x)); x[c * 8 + 2] = gelu_tanh_f(bflo(w.y)); x[c * 8 + 3] = gelu_tanh_f(bfhi(w.y));
          x[c * 8 + 4] = gelu_tanh_f(bflo(w.z)); x[c * 8 + 5] = gelu_tanh_f(bfhi(w.z)); x[c * 8 + 6] = gelu_tanh_f(bflo(w.w)); x[c * 8 + 7] = gelu_tanh_f(bfhi(w.w)); }
#pragma unroll
      for (int i = 0; i < 32; ++i) ssq += x[i] * x[i];
      ssq += __shfl_xor(ssq, 1); ssq += __shfl_xor(ssq, 2);
      const float r = 1.0f / sqrtf(ssq * (1.0f / 128.0f) + EPS);
#pragma unroll
      for (int i = 0; i < 32; ++i) { const int d = q * 32 + i; Vt[d * SGU_LD + s] = (bf16_t)f2bf(x[i] * r * vgain[g * 128 + d]); } }
    const int tt = F.wave >> 1, r = F.lane & 31, h = F.lane >> 5;
    bf16_t zu[2][16]; float bb[16];
#pragma unroll
    for (int v = 0; v < 16; ++v) { const int t = 32 * tt + crow32(v, h); bb[v] = bs[g * 128 + t];
#pragma unroll
        for (int j = 0; j < 2; ++j) zu[j][v] = Z[(size_t)(row0 + t) * DINP + ZC_ZU + g * 128 + 32 * (2 * (F.wave & 1) + j) + r]; }
    lds_barrier();
    {
#pragma unroll
      for (int j = 0; j < 2; ++j) { const int td = 2 * (F.wave & 1) + j;
          f32x16 acc = {}; acc = mma32<8>(Wl + 32 * tt * SGU_LD, SGU_LD, Vt + 32 * td * SGU_LD, SGU_LD, acc, F.lane);
          const int d = 32 * td + r;
#pragma unroll
          for (int v = 0; v < 16; ++v) { const int t = 32 * tt + crow32(v, h);
              const float ov = gelu_tanh_f(bf2f(zu[j][v])) * (acc[v] + bb[v]);
#if OUT_FP8
              MIX[(size_t)(row0 + t) * DM + 1024 + g * 128 + d] = (unsigned char)(pk2_fp8(clamp8(ov), 0.f) & 0xFF); } } }
#else
              MIX[(size_t)(row0 + t) * DM + 1024 + g * 128 + d] = (bf16_t)f2bf(ov); } } }
#endif
}

__device__ __forceinline__ int gla_row0(int b, int c) { return c < 4 ? NLAT + b * CTXL + 64 * c : b * SEQ + 64 * (c - 4); }
__device__ __forceinline__ size_t gla_sidx(int b, int c, int h, int dir) { return ((((size_t)b * NCHUNK + c) * GH + h) * 2 + dir); }
constexpr int GLD = 72;
constexpr int BCS = 65, BCD = 64 * BCS;
constexpr int GO_A = 0;
constexpr int GO_B = GO_A + 18432 + 512;
constexpr int GO_Q = GO_B + 34816;
constexpr int GO_KT = GO_Q + 4 * 9216;
constexpr int GO_VT = GO_KT + 2 * 9216;
constexpr int GO_END = GO_VT + 18432;
static_assert(GO_END <= RING_BYTES + SCR_BYTES && 2 * BCD * 4 <= 34816, "GLA LDS map");

struct GlaPre { u32x4 qw, kw, vw0, vw1; unsigned short gi[4]; float gwv[4], gbv; };
__device__ __forceinline__ void gla_local_load(const Frame& F, const int l, const int gu, GlaPre& P) {
    const int h = gu & 3, c = (gu >> 2) % NCHUNK, b = (gu >> 2) / NCHUNK; const int row0 = gla_row0(b, c);
    const bf16_t* Z = (const bf16_t*)(F.ws + WS_R + R_Z);
#pragma unroll
    for (int j = 0; j < 4; ++j) { const int i = F.tid + 512 * j; const int dir = i >> 10, tok = (i >> 4) & 63, r = i & 15; P.gi[j] = Z[(size_t)(row0 + tok) * DINP + (dir ? ZC_GGB : ZC_GGF) + r]; }
    const float* wgf = kparams()->in[I_WGF]; const float* wgb = kparams()->in[I_WGB]; const float* bgf = kparams()->in[I_BGF]; const float* bgb = kparams()->in[I_BGB];
#pragma unroll
    for (int j = 0; j < 4; ++j) { const int i = F.tid + 512 * j; const int dir = i >> 10, r = (i >> 6) & 15, d = i & 63; P.gwv[j] = (dir ? wgb : wgf)[(size_t)l * 16 * 256 + r * 256 + h * 64 + d]; }
    { const int t = F.tid & 127; const int dir = t >> 6, d = t & 63; P.gbv = (dir ? bgb : bgf)[l * 256 + h * 64 + d]; }
    const int ti = F.tid >> 3, d0 = (F.tid & 7) * 8, e0 = (F.tid & 7) * 16; const bf16_t* zr = Z + (size_t)(row0 + ti) * DINP;
    P.qw = *(const u32x4*)(zr + ZC_GQ + h * 64 + d0); P.kw = *(const u32x4*)(zr + ZC_GK + h * 64 + d0);
    P.vw0 = *(const u32x4*)(zr + ZC_GV + h * 128 + e0); P.vw1 = *(const u32x4*)(zr + ZC_GV + h * 128 + e0 + 8);
}
__device__ __forceinline__ void gla_local_unit(const Frame& F, const int l, const int gu, const GlaPre& P, const bool has_next, const int gu_next, GlaPre& N) {
    const int h = gu & 3, c = (gu >> 2) % NCHUNK, b = (gu >> 2) / NCHUNK; const int row0 = gla_row0(b, c); (void)row0;
#if GL_BF16
    bf16_t* GL = (bf16_t*)(F.ws + WS_R + R_GL);
#else
    float* GL = (float*)(F.ws + WS_R + R_GL);
#endif
    float* lamout = (float*)(F.ws + WS_GLAM) + (size_t)gu * 128;
    bf16_t* QKG = (bf16_t*)(F.ws + WS_R + R_GQK) + (size_t)gu * (4 * 64 * 64); bf16_t* VTG = (bf16_t*)(F.ws + WS_R + R_GVT) + (size_t)gu * (128 * 64);
    LAS float* gin = (LAS float*)(F.lds + GO_A);
    LAS float* gw = gin + 2048;
    LAS float* gb = gw + 2048;
    LAS float* bc = (LAS float*)(F.lds + GO_B);
    LAS bf16_t* Kft = (LAS bf16_t*)(F.lds + GO_KT); LAS bf16_t* Kbt = Kft + 64 * GLD; LAS bf16_t* Vt = (LAS bf16_t*)(F.lds + GO_VT);
#pragma unroll
    for (int j = 0; j < 4; ++j) { gin[F.tid + 512 * j] = bf2f(P.gi[j]); gw[F.tid + 512 * j] = P.gwv[j]; }
    if (F.tid < 128) gb[F.tid] = P.gbv;
    const int ti = F.tid >> 3, d0 = (F.tid & 7) * 8, e0 = (F.tid & 7) * 16;
    const u32x4 qw = P.qw, kw = P.kw, vw0 = P.vw0, vw1 = P.vw1;
    if (has_next) gla_local_load(F, l, gu_next, N);
    lds_barrier();
    for (int rp_ = 0; rp_ < GS2; ++rp_) { asm volatile("" ::: "memory");
#pragma unroll
    for (int dir = 0; dir < 2; ++dir) { const int d = F.tid & 63; float wreg[16];
#pragma unroll
        for (int r = 0; r < 16; ++r) wreg[r] = gw[(dir * 16 + r) * 64 + d];
        const float bias = gb[dir * 64 + d];
#pragma unroll
        for (int j = 0; j < 8; ++j) { const int tok = (F.tid >> 6) + 8 * j; const LAS f32x4* gp = (const LAS f32x4*)(gin + (dir * 64 + tok) * 16); float x = bias;
#pragma unroll
            for (int q = 0; q < 4; ++q) { const f32x4 gv = gp[q]; x += (gv[0] * wreg[4 * q] + gv[1] * wreg[4 * q + 1]) + (gv[2] * wreg[4 * q + 2] + gv[3] * wreg[4 * q + 3]); }
            bc[dir * BCD + tok * BCS + d] = (fminf(x, 0.f) - __logf(1.0f + __expf(-fabsf(x)))) * (1.0f / 16.0f); } } }
    lds_barrier();
    { const int dir = F.wave >> 2;
#pragma unroll 4
      for (int j = 0; j < 16; ++j) { const int d = (F.wave & 3) * 16 + j; float x = bc[dir * BCD + F.lane * BCS + d];
          if (dir == 0) {
#pragma unroll
              for (int k = 1; k < 64; k <<= 1) { const float t = __shfl_up(x, k); if (F.lane >= k) x += t; }
              if (F.lane == 63) lamout[d] = __expf(x);
          } else {
#pragma unroll
              for (int k = 1; k < 64; k <<= 1) { const float t = __shfl_down(x, k); if (F.lane + k < 64) x += t; }
              if (F.lane == 0) lamout[64 + d] = __expf(x);
          }
          bc[dir * BCD + F.lane * BCS + d] = x; } }
    lds_barrier();
    for (int rp_ = 0; rp_ < GS4; ++rp_)
    { asm volatile("" ::: "memory"); const float q[8] = {bflo(qw.x), bfhi(qw.x), bflo(qw.y), bfhi(qw.y), bflo(qw.z), bfhi(qw.z), bflo(qw.w), bfhi(qw.w)};
      const float k[8] = {bflo(kw.x), bfhi(kw.x), bflo(kw.y), bfhi(kw.y), bflo(kw.z), bfhi(kw.z), bflo(kw.w), bfhi(kw.w)};
      unsigned qf[8], kf[8], qb[8], kb[8];
#pragma unroll
      for (int j = 0; j < 8; ++j) { const int d = d0 + j; const float bf = bc[ti * BCS + d], bb = bc[BCD + ti * BCS + d];
          qf[j] = f2bf(q[j] * 0.125f * __expf(bf)); qb[j] = f2bf(q[j] * 0.125f * __expf(bb)); kf[j] = f2bf(k[j] * __expf(-bf)); kb[j] = f2bf(k[j] * __expf(-bb));
          Kft[d * GLD + ti] = (bf16_t)kf[j]; Kbt[d * GLD + ti] = (bf16_t)kb[j]; }
      u32x4* dst = (u32x4*)(QKG + ti * 64 + d0);
      dst[0] = (u32x4){qf[0] | (qf[1] << 16), qf[2] | (qf[3] << 16), qf[4] | (qf[5] << 16), qf[6] | (qf[7] << 16)};
      dst[512] = (u32x4){kf[0] | (kf[1] << 16), kf[2] | (kf[3] << 16), kf[4] | (kf[5] << 16), kf[6] | (kf[7] << 16)};
      dst[1024] = (u32x4){qb[0] | (qb[1] << 16), qb[2] | (qb[3] << 16), qb[4] | (qb[5] << 16), qb[6] | (qb[7] << 16)};
      dst[1536] = (u32x4){kb[0] | (kb[1] << 16), kb[2] | (kb[3] << 16), kb[4] | (kb[5] << 16), kb[6] | (kb[7] << 16)};
      const unsigned ww[8] = {vw0.x, vw0.y, vw0.z, vw0.w, vw1.x, vw1.y, vw1.z, vw1.w};
#pragma unroll
      for (int t = 0; t < 8; ++t) { Vt[(e0 + 2 * t) * GLD + ti] = (bf16_t)(ww[t] & 0xffffu); Vt[(e0 + 2 * t + 1) * GLD + ti] = (bf16_t)(ww[t] >> 16); } }
    lds_barrier();
    for (int rp_ = 0; rp_ < GS5; ++rp_) { asm volatile("" ::: "memory");
#pragma unroll
    for (int k = 0; k < 2; ++k) { const int id = F.tid + 512 * k, row = id >> 3, cc = id & 7; *(u32x4*)(VTG + row * 64 + cc * 8) = *(const LAS u32x4*)(Vt + row * GLD + cc * 8); }
    { const int te = F.wave >> 1, td = F.wave & 1, r = F.lane & 31, hh = F.lane >> 5;
#pragma unroll
      for (int dir = 0; dir < 2; ++dir) {
          f32x16 acc = {}; acc = mma32<4>(Vt + 32 * te * GLD, GLD, (dir ? Kbt : Kft) + 32 * td * GLD, GLD, acc, F.lane);
#if GL_BF16
          bf16_t* dst = GL + ((size_t)gu * 2 + dir) * (GDV * GDK);
#pragma unroll
          for (int v = 0; v < 16; ++v) dst[(32 * te + crow32(v, hh)) * 64 + 32 * td + r] = (bf16_t)f2bf_sw(acc[v]); } } }
#else
          float* dst = GL + ((size_t)gu * 2 + dir) * (GDV * GDK);
#pragma unroll
          for (int v = 0; v < 16; ++v) dst[(32 * te + crow32(v, hh)) * 64 + 32 * td + r] = acc[v]; } } }
#endif
}
__device__ __forceinline__ void phase_gla_scan(const Frame& F) {
#if GL_BF16
    const bf16_t* __restrict__ GL = (const bf16_t*)(F.ws + WS_R + R_GL);
#define GL_LD(p) bf2f(*(p))
#else
    const float* __restrict__ GL = (const float*)(F.ws + WS_R + R_GL);
#define GL_LD(p) NT_LD(p)
#endif
    const float* __restrict__ LAM = (const float*)(F.ws + WS_GLAM); bf16_t* __restrict__ GS = (bf16_t*)(F.ws + WS_R + R_GS);
    for (int gid = F.bid * 512 + F.tid; gid < NB * GH * 2 * 4096; gid += F.G * 512) {
        const int el = gid & 4095, dir = (gid >> 12) & 1, h = (gid >> 13) & 3, b = gid >> 15; const int d = el & 63;
        float S0 = 0.f, S1 = 0.f;
        for (int p0 = 0; p0 < NCHUNK; p0 += 17) {
            float l0[17], l1[17], lm[17];
#pragma unroll
            for (int j = 0; j < 17; ++j) { const int pstep = p0 + j; const int c = (dir == 0) ? pstep : (pstep < 4 ? 3 - pstep : 71 - pstep); const size_t si = gla_sidx(b, c, h, dir);
                l0[j] = GL_LD(GL + si * 8192 + el); l1[j] = GL_LD(GL + si * 8192 + 4096 + el); lm[j] = LAM[si * 64 + d]; }
#pragma unroll
            for (int j = 0; j < 17; ++j) { const int pstep = p0 + j; const int c = (dir == 0) ? pstep : (pstep < 4 ? 3 - pstep : 71 - pstep); const size_t si = gla_sidx(b, c, h, dir);
                GS[si * 8192 + el] = (bf16_t)f2bf(S0); GS[si * 8192 + 4096 + el] = (bf16_t)f2bf(S1);
                S0 = lm[j] * (S0 + l0[j]); S1 = lm[j] * (S1 + l1[j]); }
        }
    }
}
struct GloPre { u32x4 qk[4], vt[2], z0, z1; bf16x8 sfr[2][4]; };
__device__ __forceinline__ void gla_out_load(const Frame& F, const int gu, GloPre& P) {
    const int h = gu & 3, c = (gu >> 2) % NCHUNK, b = (gu >> 2) / NCHUNK; const int row0 = gla_row0(b, c);
    const bf16_t* Z = (const bf16_t*)(F.ws + WS_R + R_Z); const bf16_t* GS = (const bf16_t*)(F.ws + WS_R + R_GS);
    const bf16_t* QKG = (const bf16_t*)(F.ws + WS_R + R_GQK) + (size_t)gu * (4 * 64 * 64); const bf16_t* VTG = (const bf16_t*)(F.ws + WS_R + R_GVT) + (size_t)gu * (128 * 64);
    const int r = F.lane & 31, hh = F.lane >> 5, te = F.wave & 3;
#pragma unroll
    for (int k = 0; k < 4; ++k) { const int row = F.tid >> 3, cc = F.tid & 7; P.qk[k] = NT_LD((const u32x4*)(QKG + k * 4096 + row * 64 + cc * 8)); }
#pragma unroll
    for (int k = 0; k < 2; ++k) { const int id = F.tid + 512 * k, row = id >> 3, cc = id & 7; P.vt[k] = NT_LD((const u32x4*)(VTG + row * 64 + cc * 8)); }
#pragma unroll
    for (int dir = 0; dir < 2; ++dir) { const bf16_t* S = GS + ((size_t)gu * 2 + dir) * 8192 + (size_t)(32 * te + r) * 64 + 8 * hh;
#pragma unroll
        for (int ks = 0; ks < 4; ++ks) P.sfr[dir][ks] = NT_LD((const bf16x8*)(S + ks * 16)); }
    const bf16_t* zrp = Z + (size_t)(row0 + (F.tid >> 3)) * DINP + ZC_GR + h * 128 + (F.tid & 7) * 16; P.z0 = *(const u32x4*)zrp; P.z1 = *(const u32x4*)(zrp + 8);
}
__device__ __forceinline__ void gla_out_unit(const Frame& F, const int l, const int gu, const GloPre& P, const bool has_next, const int gu_next, GloPre& N) {
    const int h = gu & 3, c = (gu >> 2) % NCHUNK, b = (gu >> 2) / NCHUNK; const int row0 = gla_row0(b, c);
    MixT* MIX = (MixT*)(F.ws + WS_R + R_MIX);
    LAS bf16_t* Af = (LAS bf16_t*)(F.lds + GO_A); LAS bf16_t* Ab = Af + 64 * GLD;
    LAS float* Ol = (LAS float*)(F.lds + GO_B);
    LAS bf16_t* Qf = (LAS bf16_t*)(F.lds + GO_Q); LAS bf16_t* Kf = Qf + 64 * GLD; LAS bf16_t* Qb = Kf + 64 * GLD; LAS bf16_t* Kb = Qb + 64 * GLD;
    LAS bf16_t* Vt = (LAS bf16_t*)(F.lds + GO_VT);
    const float* ogain = kparams()->in[I_GLAON] + l * 128;
#pragma unroll
    for (int k = 0; k < 4; ++k) { const int row = F.tid >> 3, cc = F.tid & 7; *(LAS u32x4*)(Qf + k * 64 * GLD + row * GLD + cc * 8) = P.qk[k]; }
#pragma unroll
    for (int k = 0; k < 2; ++k) { const int id = F.tid + 512 * k, row = id >> 3, cc = id & 7; *(LAS u32x4*)(Vt + row * GLD + cc * 8) = P.vt[k]; }
    const int r = F.lane & 31, hh = F.lane >> 5;
    bf16x8 sfr[2][4];
#pragma unroll
    for (int dir = 0; dir < 2; ++dir)
#pragma unroll
        for (int ks = 0; ks < 4; ++ks) sfr[dir][ks] = P.sfr[dir][ks];
    const u32x4 z0 = P.z0, z1 = P.z1;
    if (has_next) gla_out_load(F, gu_next, N);
    lds_barrier();
    { const int dir = F.wave >> 2, ti = (F.wave >> 1) & 1, tj = F.wave & 1;
      f32x16 acc = {}; acc = mma32<4>((dir ? Qb : Qf) + 32 * ti * GLD, GLD, (dir ? Kb : Kf) + 32 * tj * GLD, GLD, acc, F.lane);
      LAS bf16_t* A = dir ? Ab : Af; const int j = 32 * tj + r;
#pragma unroll
      for (int v = 0; v < 16; ++v) { const int i = 32 * ti + crow32(v, hh); const bool keep = dir ? (j >= i) : (j <= i);
          A[i * GLD + j] = (bf16_t)f2bf(keep ? acc[v] : 0.f); } }
    lds_barrier();
    { const int ti = F.wave >> 2, te = F.wave & 3;
      f32x16 acc = {};
      acc = mma32<4>(Af + 32 * ti * GLD, GLD, Vt + 32 * te * GLD, GLD, acc, F.lane);
      acc = mma32<4>(Ab + 32 * ti * GLD, GLD, Vt + 32 * te * GLD, GLD, acc, F.lane);
#pragma unroll
      for (int dir = 0; dir < 2; ++dir) { const LAS bf16_t* Qx = (dir ? Qb : Qf) + (32 * ti + r) * GLD + 8 * hh;
#pragma unroll
          for (int ks = 0; ks < 4; ++ks) { const bf16x8 a = *(const LAS bf16x8*)(Qx + ks * 16);
              acc = __builtin_amdgcn_mfma_f32_32x32x16_bf16(a, sfr[dir][ks], acc, 0, 0, 0); } }
#pragma unroll
      for (int v = 0; v < 16; ++v) Ol[(32 * ti + crow32(v, hh)) * 132 + 32 * te + r] = acc[v]; }
    lds_barrier();
    { const int i = F.tid >> 3, e0 = (F.tid & 7) * 16; float o[16]; float ssq = 0.f;
#pragma unroll
      for (int t = 0; t < 16; ++t) { o[t] = Ol[i * 132 + e0 + t]; ssq += o[t] * o[t]; }
      ssq += __shfl_xor(ssq, 1); ssq += __shfl_xor(ssq, 2); ssq += __shfl_xor(ssq, 4);
      const float rn = 1.0f / sqrtf(ssq * (1.0f / 128.0f) + EPS);
      MixT* mp = MIX + (size_t)(row0 + i) * DM + 1536 + h * 128 + e0;
      const unsigned zz[8] = {z0.x, z0.y, z0.z, z0.w, z1.x, z1.y, z1.z, z1.w};
#if OUT_FP8
      float a[16];
#pragma unroll
      for (int t = 0; t < 8; ++t) { a[2 * t] = clamp8(o[2 * t] * rn * ogain[e0 + 2 * t] * silu_f(bflo(zz[t]))); a[2 * t + 1] = clamp8(o[2 * t + 1] * rn * ogain[e0 + 2 * t + 1] * silu_f(bfhi(zz[t]))); }
      *(u32x4*)mp = (u32x4){pk4_fp8(a[0], a[1], a[2], a[3]), pk4_fp8(a[4], a[5], a[6], a[7]), pk4_fp8(a[8], a[9], a[10], a[11]), pk4_fp8(a[12], a[13], a[14], a[15])}; }
#else
      unsigned w[8];
#pragma unroll
      for (int t = 0; t < 8; ++t) { const float a0 = o[2 * t] * rn * ogain[e0 + 2 * t] * silu_f(bflo(zz[t])), a1 = o[2 * t + 1] * rn * ogain[e0 + 2 * t + 1] * silu_f(bfhi(zz[t])); w[t] = cvt_pk_bf16(a0, a1); }
      *(u32x4*)mp = (u32x4){w[0], w[1], w[2], w[3]}; *(u32x4*)(mp + 8) = (u32x4){w[4], w[5], w[6], w[7]}; }
#endif
}

__device__ __forceinline__ void phase_router(const Frame& F, const int l, const int nrows) {
    LAS float* Wg = (LAS float*)F.lds;
    LAS bf16_t* We = (LAS bf16_t*)(F.lds + 4 * 2048 * 4);
    LAS int* lcnt = (LAS int*)F.scr;
    LAS int* lbase = lcnt + 16;
    LAS int* rec = lcnt + 32;
    const float* wgs = kparams()->in[I_MWG] + (size_t)l * 2048 * 4; const float* wes = kparams()->in[I_MWE] + (size_t)l * 2048 * 16;
    for (int k = F.tid; k < 2048; k += 512) { const f32x4 g = *(const f32x4*)(wgs + k * 4);
#pragma unroll
        for (int o = 0; o < 4; ++o) Wg[o * 2048 + k] = g[o];
#pragma unroll
        for (int q = 0; q < 4; ++q) { const f32x4 e = *(const f32x4*)(wes + k * 16 + 4 * q);
#pragma unroll
            for (int o = 0; o < 4; ++o) We[(4 * q + o) * 2048 + k] = (bf16_t)f2bf(e[o]); } }
    if (F.tid < 16) lcnt[F.tid] = 0;
    __syncthreads();
    const int RPB = nrows / F.G;
    const bf16_t* X1 = (const bf16_t*)(F.ws + WS_X1); unsigned* H8 = (unsigned*)(F.ws + WS_H);
    const float* modl = (const float*)(F.ws + WS_MOD) + (size_t)l * 5 * 12288; const float* n2g = kparams()->in[I_N2G] + l * 2048;
    const float* bg = kparams()->in[I_MBG] + l * 4; const float* be = kparams()->in[I_MBE] + l * 16;
    float* cw = (float*)(F.ws + WS_CW);
    typedef __bf16 bf16x2_t __attribute__((ext_vector_type(2)));
    LAS float* lgs = (LAS float*)(F.lds + 4 * 2048 * 4 + 16 * 2048 * 2) + F.wave * 64;
    for (int rrep = 0; rrep < RP_RT; ++rrep)
    for (int it = 0; it * 16 + 2 * F.wave < RPB; ++it) {
        const int rl0 = it * 16 + 2 * F.wave;
        f32x4 v[2][8]; unsigned hb[2][16]; float rr[2];
#pragma unroll
        for (int q = 0; q < 2; ++q) { const bf16_t* src = X1 + (size_t)(F.bid * RPB + rl0 + q) * DM; float s = 0.f;
#pragma unroll
            for (int i = 0; i < 8; ++i) { const u32x2 xw = *(const u32x2*)(src + 256 * i + 4 * F.lane); v[q][i] = (f32x4){bflo(xw.x), bfhi(xw.x), bflo(xw.y), bfhi(xw.y)}; s += (v[q][i][0] * v[q][i][0] + v[q][i][1] * v[q][i][1]) + (v[q][i][2] * v[q][i][2] + v[q][i][3] * v[q][i][3]); }
            rr[q] = s; }
#pragma unroll
        for (int q = 0; q < 2; ++q) { const int row = F.bid * RPB + rl0 + q; const int mr = mod_row_of(row);
            const float* msh = modl + (size_t)mr * 12288 + 3 * DM; const float* msc = modl + (size_t)mr * 12288 + 4 * DM;
            const float r = 1.0f / sqrtf(wave_sum(rr[q]) * (1.0f / DM) + EPS);
            unsigned* hp = H8 + (size_t)row * (MOE_FP8 ? DM / 4 : DM / 2);
#pragma unroll
            for (int i = 0; i < 8; ++i) { const int k = 256 * i + 4 * F.lane; const f32x4 g = *(const f32x4*)(n2g + k), sc = *(const f32x4*)(msc + k), sh = *(const f32x4*)(msh + k);
                v[q][i] = v[q][i] * r * g * (sc + 1.0f) + sh;
                hb[q][2 * i] = cvt_pk_bf16(v[q][i][0], v[q][i][1]); hb[q][2 * i + 1] = cvt_pk_bf16(v[q][i][2], v[q][i][3]);
#if MOE_FP8
                hp[64 * i + F.lane] = pk4_fp8(v[q][i][0], v[q][i][1], v[q][i][2], v[q][i][3]); }
#else
                *(u32x2*)((bf16_t*)hp + k) = (u32x2){hb[q][2 * i], hb[q][2 * i + 1]}; }
#endif
        }
        float p[2][32];
#pragma unroll
        for (int q = 0; q < 2; ++q)
#pragma unroll
            for (int o = 20; o < 32; ++o) p[q][o] = 0.f;
#pragma unroll
        for (int o = 0; o < 4; ++o) { float a0 = 0.f, a1 = 0.f;
#pragma unroll
            for (int i = 0; i < 8; ++i) { const f32x4 w = *(const LAS f32x4*)(Wg + o * 2048 + 256 * i + 4 * F.lane);
                a0 += (v[0][i][0] * w[0] + v[0][i][1] * w[1]) + (v[0][i][2] * w[2] + v[0][i][3] * w[3]); a1 += (v[1][i][0] * w[0] + v[1][i][1] * w[1]) + (v[1][i][2] * w[2] + v[1][i][3] * w[3]); }
            p[0][o] = a0; p[1][o] = a1; }
#pragma unroll
        for (int o = 0; o < 16; ++o) { float a0 = 0.f, a1 = 0.f;
#pragma unroll
            for (int i = 0; i < 8; ++i) { const u32x2 w = *(const LAS u32x2*)(We + o * 2048 + 256 * i + 4 * F.lane);
                const bf16x2_t wx = __builtin_bit_cast(bf16x2_t, w.x), wy = __builtin_bit_cast(bf16x2_t, w.y);
#ifndef RT_DOT2
                a0 += (bflo(hb[0][2 * i]) * bflo(w.x) + bfhi(hb[0][2 * i]) * bfhi(w.x)) + (bflo(hb[0][2 * i + 1]) * bflo(w.y) + bfhi(hb[0][2 * i + 1]) * bfhi(w.y));
                a1 += (bflo(hb[1][2 * i]) * bflo(w.x) + bfhi(hb[1][2 * i]) * bfhi(w.x)) + (bflo(hb[1][2 * i + 1]) * bflo(w.y) + bfhi(hb[1][2 * i + 1]) * bfhi(w.y)); (void)wx; (void)wy; }
#else
                a0 = __builtin_amdgcn_fdot2_f32_bf16(__builtin_bit_cast(bf16x2_t, hb[0][2 * i]), wx, a0, false); a0 = __builtin_amdgcn_fdot2_f32_bf16(__builtin_bit_cast(bf16x2_t, hb[0][2 * i + 1]), wy, a0, false);
                a1 = __builtin_amdgcn_fdot2_f32_bf16(__builtin_bit_cast(bf16x2_t, hb[1][2 * i]), wx, a1, false); a1 = __builtin_amdgcn_fdot2_f32_bf16(__builtin_bit_cast(bf16x2_t, hb[1][2 * i + 1]), wy, a1, false); }
#endif
            p[0][4 + o] = a0; p[1][4 + o] = a1; }
#define FOLD(N, OFF) do { const bool up = (F.lane & (OFF)) != 0; _Pragma("unroll") for (int q = 0; q < 2; ++q) _Pragma("unroll") for (int j = 0; j < (N) / 2; ++j) { \
            const float snd = up ? p[q][j] : p[q][j + (N) / 2], kp = up ? p[q][j + (N) / 2] : p[q][j]; p[q][j] = kp + __shfl_xor(snd, (OFF)); } } while (0)
        FOLD(32, 32); FOLD(16, 16); FOLD(8, 8); FOLD(4, 4); FOLD(2, 2);
#undef FOLD
        const int idx = ((F.lane >> 5) & 1) * 16 + ((F.lane >> 4) & 1) * 8 + ((F.lane >> 3) & 1) * 4 + ((F.lane >> 2) & 1) * 2 + ((F.lane >> 1) & 1);
#pragma unroll
        for (int q = 0; q < 2; ++q) { const float tot = p[q][0] + __shfl_xor(p[q][0], 1); if ((F.lane & 1) == 0) lgs[q * 32 + idx] = tot; }
        LDS_WAIT(); asm volatile("" ::: "memory");
#pragma unroll
        for (int q = 0; q < 2; ++q) { const int row = F.bid * RPB + rl0 + q;
            float lg[4], le[16];
#pragma unroll
            for (int o = 0; o < 4; ++o) lg[o] = lgs[q * 32 + o] + bg[o];
#pragma unroll
            for (int o = 0; o < 16; ++o) le[o] = lgs[q * 32 + 4 + o] + be[o];
            int gsel = 0; float gm = lg[0];
#pragma unroll
            for (int o = 1; o < 4; ++o) if (lg[o] > gm) { gm = lg[o]; gsel = o; }
            float gden = 0.f;
#pragma unroll
            for (int o = 0; o < 4; ++o) gden += __expf(lg[o] - gm);
            const float gwt = 1.0f / gden;
            float el[4];
#pragma unroll
            for (int j = 0; j < 4; ++j) el[j] = gsel == 0 ? le[j] : gsel == 1 ? le[4 + j] : gsel == 2 ? le[8 + j] : le[12 + j];
            int i0 = 0; float m0 = el[0];
#pragma unroll
            for (int j = 1; j < 4; ++j) if (el[j] > m0) { m0 = el[j]; i0 = j; }
            int i1 = -1; float m1 = -3.0e38f;
#pragma unroll
            for (int j = 0; j < 4; ++j) if (j != i0 && el[j] > m1) { m1 = el[j]; i1 = j; }
            const float ex = __expf(m1 - m0); const float w0 = 1.0f / (1.0f + ex), w1 = ex / (1.0f + ex);
            if (F.lane == 0 && rrep == RP_RT - 1) { const int e0 = 4 * gsel + i0, e1 = 4 * gsel + i1; const int rl = rl0 + q;
                const int x0 = atomicAdd((int*)(lcnt + e0), 1), x1 = atomicAdd((int*)(lcnt + e1), 1);
                rec[rl * 4 + 0] = e0; rec[rl * 4 + 1] = e1; rec[rl * 4 + 2] = x0; rec[rl * 4 + 3] = x1;
                cw[row * 2] = gwt * w0; cw[row * 2 + 1] = gwt * w1; } }
        LDS_WAIT(); asm volatile("" ::: "memory");
    }
    __syncthreads();
    unsigned* gcnt = F.ctl + CW_CNT + l * 64;
    if (F.tid < 16) lbase[F.tid] = (int)__hip_atomic_fetch_add(gcnt + F.tid, (unsigned)lcnt[F.tid], __ATOMIC_RELAXED, __HIP_MEMORY_SCOPE_AGENT);
    __syncthreads();
    if (F.tid < RPB) { const int row = F.bid * RPB + F.tid; int* te = (int*)(F.ws + WS_TOKE); int* ti = (int*)(F.ws + WS_TOKI);
        const int e0 = rec[F.tid * 4], e1 = rec[F.tid * 4 + 1];
        const int x0 = lbase[e0] + rec[F.tid * 4 + 2], x1 = lbase[e1] + rec[F.tid * 4 + 3];
        te[row * 2] = e0; te[row * 2 + 1] = e1; ti[row * 2] = x0; ti[row * 2 + 1] = x1;
#if MOE_GATHER
        unsigned short* list = (unsigned short*)(F.ws + WS_LIST); list[(size_t)e0 * NTOK + x0] = (unsigned short)row; list[(size_t)e1 * NTOK + x1] = (unsigned short)row;
#endif
    }
    __syncthreads();
}
__device__ __forceinline__ void phase_permute(const Frame& F, const int l, const int nrows) {
    LAS int* tstart = (LAS int*)(F.scr + 8192);
    moe_table(F, l, tstart);
    const unsigned char* H = F.ws + WS_H; unsigned char* H2S = F.ws + WS_R + R_H2S;
    const int* te = (const int*)(F.ws + WS_TOKE); const int* ti = (const int*)(F.ws + WS_TOKI); int* ts = (int*)(F.ws + WS_TOKS);
    const int gw = F.bid * 8 + F.wave, NGW = F.G * 8;
    for (int row = gw; row < nrows; row += NGW) {
        const int s0 = tstart[te[row * 2]] * 256 + ti[row * 2], s1 = tstart[te[row * 2 + 1]] * 256 + ti[row * 2 + 1];
        if (F.lane == 0) { ts[row * 2] = s0; ts[row * 2 + 1] = s1; }
        constexpr int RB = MOE_FP8 ? DM : DM * 2;
        const u32x4* src = (const u32x4*)(H + (size_t)row * RB) + F.lane; u32x4* d0 = (u32x4*)(H2S + (size_t)s0 * RB) + F.lane; u32x4* d1 = (u32x4*)(H2S + (size_t)s1 * RB) + F.lane;
#pragma unroll
        for (int i = 0; i < RB / 1024; ++i) { const u32x4 x = NT_LD(src + 64 * i); d0[64 * i] = x; d1[64 * i] = x; }
    }
}

#define REPEAT(n) for (int rep_ = 0; rep_ < (n); ++rep_)
constexpr int NPH = 11, NPHASES = DEPTH * NPH + 1;
#if MK_ONE_LAUNCH
#define GRID_BAR() do { for (int rb_ = 0; rb_ < RP_BAR; ++rb_) xcd_barrier(bar); } while (0)
#else
#define GRID_BAR() do {} while (0)
#endif
#ifdef ONLY_PHASE
#define IN(k) ((((k) % NPH) == ONLY_PHASE || ((k) == DEPTH * NPH && ONLY_PHASE == NPH)) && lo <= (k) && (k) < hi)
#else
#define IN(k) (lo <= (k) && (k) < hi)
#endif
#define SEAM(k) do { if (IN(k) && IN((k) + 1)) GRID_BAR(); } while (0)
#define PHASE_FRAME() Frame F; { F.lds = (LAS unsigned char*)lds_raw; F.scr = F.lds + SCR_OFF; F.MISC = (volatile LAS unsigned*)(F.lds + MISC_OFF); \
        int tz = wave_s * 64 + lane_id(); asm volatile("" : "+v"(tz)); F.tid = tz; F.lane = tz & 63; F.wave = __builtin_amdgcn_readfirstlane(tz >> 6); \
        int bz = blockIdx.x; asm volatile("" : "+s"(bz)); F.G = gridDim.x; F.bid = bz; \
        F.ws = kparams()->ws; F.ctl = (unsigned*)(F.ws + WS_CTL); } \
        unsigned char* const wb = F.ws + WS_W + (size_t)PF_LAYER * WL_BYTES; unsigned char* const R = F.ws + WS_R; (void)wb; (void)R

#ifndef W_PRE16
#define W_PRE16 0
#endif
template <int l>
__device__ __forceinline__ void layer_body(unsigned char* lds_raw, const int wave_s, const int lo, const int hi, const XcdBarrier& bar) {
    constexpr int P0 = l * NPH; constexpr bool ctx_out = (l < DEPTH - 1); constexpr int PF_LAYER = l;
    constexpr int WPRE = (l >= 1) ? W_PRE16 : 0;
    constexpr int nrows = ctx_out ? NTOK : NLAT, nMt = nrows / 256;
    if (IN(P0 + 0)) REPEAT(RP_W) { PHASE_FRAME(); phase_weights(F, l, WPRE, 16, F.G, F.bid, true, (W_FILL != 0 && l >= 1) ? (int)F.MISC[32 + F.wave] : 0); if (RP_W > 1) __syncthreads(); } SEAM(P0 + 0);
    if (IN(P0 + 1)) REPEAT(RP_ROWS) { PHASE_FRAME(); phase_rows<(l == 0) ? 0 : 1>(F, l); if (RP_ROWS > 1) __syncthreads(); } SEAM(P0 + 1);
    if (IN(P0 + 2)) { PHASE_FRAME(); TileSched S; S.init(F.ws + WS_H, DM, wb + W_IN, DM, NTOK / 256, DINP / 256, F.G, F.bid, RP_GIN);
        EpiZ E{(bf16_t*)(R + R_Z), (float*)(F.ws + WS_RSQ)};
        pg8::gemm_phase<EpiZ, TileSched, false, ALIGN_PLAIN>(F.tid, F.lds, F.scr, DM * 2, DM * 2, S, E); } SEAM(P0 + 2);
    if (IN(P0 + 3)) { PHASE_FRAME(); UpSched S; S.rep = RP_UP; S.Z = (const char*)(R + R_Z); S.Wq = (const char*)(wb + W_UQ); S.Wkv = (const char*)(wb + W_UKV); S.nQ = nMt * 8; S.ntot = S.nQ + (NTOK / 256) * 8; S.G = F.G; S.c = F.bid;
        EpiUp E{(const bf16_t*)(R + R_Z), (const float*)(F.ws + WS_RSQ), kparams()->in[I_QGAIN] + l * QKD, kparams()->in[I_KGAIN] + l * QKD, (const f32x2*)(F.ws + WS_ROPE), (bf16_t*)(R + R_Q), (bf16_t*)(R + R_K), (bf16_t*)(R + R_V)};
        pg8::gemm_phase<EpiUp, UpSched>(F.tid, F.lds, F.scr, DINP * 2, 512 * 2, S, E); }
    if (IN(P0 + 3)) { PHASE_FRAME();
        unsigned* qh = F.ctl + CW_Q + 64 * (4 * l + 0); constexpr int nS = (ctx_out ? 136 : 128) * 4;
        constexpr bool FILL = ((W_FILL & 1) != 0) && (l + 1 < DEPTH); int wdone = FILL ? (int)F.MISC[32 + F.wave] : 0; LAS unsigned* wscr = (LAS unsigned*)(F.lds + 2 * 128 * SGU_LD * 2 + F.wave * 4608);
        UnitQ q; q_first(F, qh, q); for (;;) { int u, un; q_next(F, qh, q, u, un); if (u >= nS * RP_SGU) break;
            if constexpr (FILL) { const int kq = F.lane >> 3, n4 = F.lane & 7; LAS unsigned* scr = wscr; WF_DECL(); WF_LOAD(l + 1, wdone); sgu_unit(F, l, u % nS); WF_STORE(wdone); } else sgu_unit(F, l, u % nS); }
        if (FILL && F.lane == 0) F.MISC[32 + F.wave] = (unsigned)wdone; }
    if (IN(P0 + 3)) { PHASE_FRAME();
        unsigned* qh = F.ctl + CW_Q + 64 * (4 * l + 3); constexpr int nG = NB * NCHUNK * GH;
        constexpr bool FILL = ((W_FILL & 2) != 0) && (l + 1 < DEPTH); int wdone = FILL ? (int)F.MISC[32 + F.wave] : 0; LAS unsigned* wscr = (LAS unsigned*)(F.lds + GO_Q + F.wave * 4608);
        UnitQ q; q_first(F, qh, q); GlaPre PA, PB; bool first = true;
        for (;;) { int u, un; q_next(F, qh, q, u, un); if (u >= nG * RP_GLAL) break;
            if (first) { gla_local_load(F, l, u % nG, PA); first = false; }
            if constexpr (FILL) { const int kq = F.lane >> 3, n4 = F.lane & 7; LAS unsigned* scr = wscr; WF_DECL(); WF_LOAD(l + 1, wdone); gla_local_unit(F, l, u % nG, PA, un < nG * RP_GLAL, un % nG, PB); WF_STORE(wdone); }
            else gla_local_unit(F, l, u % nG, PA, un < nG * RP_GLAL, un % nG, PB);
            PA = PB; }
        if (FILL && F.lane == 0) F.MISC[32 + F.wave] = (unsigned)wdone; } SEAM(P0 + 3);
    if (IN(P0 + 4)) { PHASE_FRAME(); REPEAT(RP_SCAN) phase_gla_scan(F);
        VM_WAIT(); __syncthreads();
        if (F.tid == 0) { __builtin_amdgcn_fence(__ATOMIC_RELEASE, "agent"); asm volatile("s_waitcnt vmcnt(0)" ::: "memory");
            __hip_atomic_fetch_add(F.ctl + CW_Q + 64 * (4 * l + 1), 1u, __ATOMIC_RELAXED, __HIP_MEMORY_SCOPE_AGENT); } }
    if (IN(P0 + 4)) { PHASE_FRAME();
        const bf16_t* Qb = (const bf16_t*)(R + R_Q); const bf16_t* Kb = (const bf16_t*)(R + R_K); const bf16_t* Vb = (const bf16_t*)(R + R_V); MixT* MIX = (MixT*)(R + R_MIX);
        constexpr int nlat = NB * NH * (SEQ / 256), nun = nlat + (ctx_out ? NB * NH : 0);
        for (int un_ = F.bid; un_ < nun * RP_ATTN; un_ += F.G) { const int un = un_ % nun;
            int qrow, h, rowA, rowB, NT;
            if (un < nlat) {
                int pr, qb; if ((F.G & 7) == 0 && F.G == 256) { const int xcd = un & 7, idx = (un >> 3) & 31, rnd = un >> 8; pr = 4 * xcd + 2 * rnd + (idx >> 4); qb = idx & 15; } else { pr = un >> 4; qb = un & 15; }
                const int b = pr >> 3; h = pr & 7; qrow = b * SEQ + qb * 256; rowA = NLAT + b * CTXL; rowB = b * SEQ; NT = (CTXL + SEQ) / 64; }
            else { const int u2 = un - nlat, b = u2 >> 3; h = u2 & 7; qrow = NLAT + b * CTXL; rowA = qrow; rowB = 0; NT = CTXL / 64; }
            attn::attn_body(F.tid, Qb + (size_t)qrow * QLD + h * QKD, Kb + h * QKD, Vb + h * VD, MIX + (size_t)qrow * DM + h * VD, rowA, CTXL / 64, rowB, NT, (char*)lds_raw);
        } }
    if (IN(P0 + 4)) { PHASE_FRAME();
        if (F.tid == 0) { unsigned* flag = F.ctl + CW_Q + 64 * (4 * l + 1); unsigned sp = 0;
            while (__hip_atomic_load(flag, __ATOMIC_RELAXED, __HIP_MEMORY_SCOPE_AGENT) < (unsigned)F.G) { __builtin_amdgcn_s_sleep(2); if (++sp > (1u << 22)) break; }
            __builtin_amdgcn_fence(__ATOMIC_ACQUIRE, "agent"); asm volatile("s_waitcnt vmcnt(0)" ::: "memory"); }
        __syncthreads();
        unsigned* qh = F.ctl + CW_Q + 64 * (4 * l + 2); constexpr int nO = NB * (ctx_out ? NCHUNK : NCHUNK - 4) * GH;
        UnitQ q; q_first(F, qh, q); GloPre PA, PB; bool first = true;
        auto gmap = [&](int u) { int gu = u; if (!ctx_out) { const int hq = u & 3, cc = 4 + ((u >> 2) & 63), bb = u >> 8; gu = ((bb * NCHUNK + cc) * GH) + hq; } return gu; };
        for (;;) { int u_, un_; q_next(F, qh, q, u_, un_); if (u_ >= nO * RP_GLAO) break;
            const int gu = gmap(u_ % nO), gun = gmap(un_ % nO);
            if (first) { gla_out_load(F, gu, PA); first = false; }
            gla_out_unit(F, l, gu, PA, un_ < nO * RP_GLAO, gun, PB); PA = PB; } } SEAM(P0 + 4);
    if (IN(P0 + 6)) { PHASE_FRAME(); const float* modl = (const float*)(F.ws + WS_MOD) + (size_t)l * 5 * 12288; constexpr int OEB = OUT_FP8 ? 1 : 2; TileSched S; S.init(R + R_MIX, DM * OEB / 2, wb + W_OUT, DM * OEB / 2, nMt, DM / 256, F.G, F.bid, RP_OUT);
        if constexpr (l == 0) { EpiResid<false> E{kparams()->in[I_X], kparams()->in[I_CTX], modl, (bf16_t*)(F.ws + WS_X1)};
            pg8::gemm_phase<EpiResid<false>, TileSched, OUT_FP8 != 0, ALIGN_F8, F8_SP2>(F.tid, F.lds, F.scr, DM * OEB, DM * OEB, S, E); }
        else { EpiResid<true> E{F.ws + WS_X2, F.ws + WS_X2 + (size_t)NLAT * DM * 2, modl, (bf16_t*)(F.ws + WS_X1)};
            pg8::gemm_phase<EpiResid<true>, TileSched, OUT_FP8 != 0, ALIGN_F8, F8_SP2>(F.tid, F.lds, F.scr, DM * OEB, DM * OEB, S, E); } }
    if (IN(P0 + 6) && l + 1 < DEPTH && W_PRE16 > 0) { PHASE_FRAME(); constexpr int nbusy = (nMt * (DM / 256)) % 256;
        if (F.G == 256 && F.bid >= nbusy) phase_weights(F, l + 1, 0, W_PRE16, F.G - nbusy, F.bid - nbusy, false); } SEAM(P0 + 6);
    if (IN(P0 + 7)) { PHASE_FRAME(); phase_router(F, l, nrows); } SEAM(P0 + 7);
#if !MOE_GATHER
    if (IN(P0 + 8)) REPEAT(RP_PERM) { PHASE_FRAME(); phase_permute(F, l, nrows); if (RP_PERM > 1) __syncthreads(); } SEAM(P0 + 8);
#endif
    if (IN(P0 + 9)) { PHASE_FRAME(); LAS int* tstart = (LAS int*)(F.scr + 8192); moe_table(F, l, tstart);
        constexpr int EB = MOE_FP8 ? 1 : 2;
#if MOE_GATHER
        MoeSchedG S; S.A = (const char*)(F.ws + WS_H);
#else
        MoeSched S; S.A = (const char*)(R + R_H2S);
#endif
        S.W = (const char*)(wb + W_GU); S.a_tile = 256 * (size_t)DM * EB; S.w_exp = (size_t)2048 * 2048 * EB; S.b_tile = 256 * (size_t)2048 * EB;
        S.tstart = tstart; S.ntot = tstart[16] * 8; S.G = F.G; S.c = F.bid; S.rep = RP_M1;
#if MOE_GATHER
        { LAS unsigned* gtab = (LAS unsigned*)F.scr; S.gtab = gtab; const unsigned short* list = (const unsigned short*)(F.ws + WS_LIST);
          for (int i = 0; i < 8; ++i) { pg8::Unit u; if (!S.next(i, u)) break;
              if (F.tid < 256) { const int e = u.aux, idx = (u.pm - tstart[e]) * 256 + F.tid; const unsigned tok = idx < tstart[32 + e] ? (unsigned)list[(size_t)e * NTOK + idx] : 0u; gtab[i * 256 + F.tid] = tok * (unsigned)(DM * EB); } }
          __syncthreads(); }
#endif
        EpiSwiglu E{R + R_ACT};
        pg8::gemm_phase<EpiSwiglu, decltype(S), MOE_FP8 != 0, ALIGN_F8, F8_SP2>(F.tid, F.lds, F.scr, DM * EB, DM * EB, S, E); } SEAM(P0 + 9);
    if (IN(P0 + 10)) { PHASE_FRAME(); LAS int* tstart = (LAS int*)(F.scr + 8192); moe_table(F, l, tstart);
        MoeSched S; S.A = (const char*)(R + R_ACT); S.W = (const char*)(wb + W_2); constexpr int EB = MOE_FP8 ? 1 : 2; S.a_tile = 256 * (size_t)DEXP * EB; S.w_exp = (size_t)2048 * 1024 * EB; S.b_tile = 256 * (size_t)1024 * EB;
        S.tstart = tstart; S.ntot = tstart[16] * 8; S.G = F.G; S.c = F.bid; S.rep = RP_M2;
        EpiBf16 E{(bf16_t*)(R + R_Y), DM};
        pg8::gemm_phase<EpiBf16, MoeSched, MOE_FP8 != 0, ALIGN_F8, F8_SP2>(F.tid, F.lds, F.scr, DEXP * EB, DEXP * EB, S, E); }
    if constexpr (l + 1 < DEPTH && MK_ONE_LAUNCH) {   } else SEAM(P0 + 10);
}

__global__ void __launch_bounds__(512, 2) hybrid_fwd(Params p) {
    extern __shared__ __attribute__((aligned(16))) unsigned char lds_raw[];
    const int wave_s = __builtin_amdgcn_readfirstlane((int)threadIdx.x >> 6);
    { LAS unsigned* m = (LAS unsigned*)((LAS unsigned char*)lds_raw + MISC_OFF); if (wave_s == 0) m[lane_id()] = 0u; }
    __syncthreads();
#if MK_ONE_LAUNCH
    const XcdBarrier bar = xcd_barrier_post((unsigned*)(kparams()->ws + WS_CTL) + CW_BAR, (volatile LAS unsigned*)((LAS unsigned char*)lds_raw + MISC_OFF) + 8);
#else
    XcdBarrier bar; bar.bar = nullptr; bar.x = 0; bar.st = nullptr;
#endif
    const int lo = kparams()->ph_lo, hi = kparams()->ph_hi;
    layer_body<0>(lds_raw, wave_s, lo, hi, bar);
    layer_body<1>(lds_raw, wave_s, lo, hi, bar);
    if (IN(DEPTH * NPH)) { constexpr int PF_LAYER = DEPTH - 1; PHASE_FRAME(); phase_rows<2>(F, DEPTH - 1); }
}
#undef IN
#undef SEAM
#undef GRID_BAR
static_assert(DEPTH == 2, "two layer_body instantiations");

extern "C" void kernel_launch(void* const* d_in, const int* in_sizes, int n_in, void* d_out, int out_size, void* d_ws, size_t ws_size, hipStream_t stream) {
    static int grid = 0;
    if (grid == 0) {
        if (n_in != 31 || out_size != NLAT * DM || ws_size < WS_END) { fprintf(stderr, "kernel_launch: unexpected shapes (n_in %d, out %d, ws %zu, need %zu)\n", n_in, out_size, ws_size, (size_t)WS_END); grid = -1; return; }
        int dev = 0, cus = 0, per_cu = 0;
        if (hipGetDevice(&dev) != hipSuccess || hipDeviceGetAttribute(&cus, hipDeviceAttributeMultiprocessorCount, dev) != hipSuccess) { grid = -1; return; }
        if (hipFuncSetAttribute((const void*)hybrid_fwd, hipFuncAttributeMaxDynamicSharedMemorySize, LDS_BYTES) != hipSuccess) { fprintf(stderr, "kernel_launch: hipFuncSetAttribute failed\n"); grid = -1; return; }
        if (hipOccupancyMaxActiveBlocksPerMultiprocessor(&per_cu, (const void*)hybrid_fwd, 512, LDS_BYTES) != hipSuccess || per_cu < 1) { fprintf(stderr, "kernel_launch: occupancy query reports %d\n", per_cu); }
        (void)hipGetLastError();
        grid = cus;
        if (grid > 256) grid = 256;
    }
    if (grid < 0) return;
    (void)hipMemsetAsync((char*)d_ws + WS_CTL, 0, CTL_ZERO_BYTES, stream);
    Params a{};
    for (int i = 0; i < 31; ++i) a.in[i] = (const float*)d_in[i];
    a.out = (float*)d_out; a.ws = (unsigned char*)d_ws;
#if MK_ONE_LAUNCH
    a.ph_lo = 0; a.ph_hi = NPHASES;
    hipLaunchKernelGGL(hybrid_fwd, dim3(grid), dim3(512), LDS_BYTES, stream, a);
#else
    for (int ph = 0; ph < NPHASES; ++ph) { a.ph_lo = ph; a.ph_hi = ph + 1; hipLaunchKernelGGL(hybrid_fwd, dim3(grid), dim3(512), LDS_BYTES, stream, a); }
#endif
}
```
